# Optimizing an MI355X kernel written in HIP

```python
import numpy as np
import jax
import jax.numpy as jnp
from jax import lax

D_MODEL = 1024
BATCH = 1
SEQ = 16384
DEPTH = 4
DEC_BATCH = 8
DEC_SEQ = 2048
PAST_LEN = 128

N_MIXERS = 4
HEAD_DIM = 64
D_FF = 2816
NORM_EPS = 1e-6
NEG_INF = -1e30
Q_BLOCK = 128
GRID_W = 64
ROPE_THETA = 10000.0
RESIDUAL_HALF = 0.5

A_HEADS = 16
A_KV_HEADS = 4
A_HALF_WINDOW = 128
B_HEADS = 16
B_Q_LORA = 512
B_KV_LORA = 256
B_NOPE = 64
B_ROPE = 32
B_V = 64
C_HEADS = 8
C_PATTERNS = ((128, 1), (512, 4), (2048, 16))
D_HEADS = 16
D_KV_HEADS = 4

kernel_name = "hybrid_bidir_encoder_interleaved"


def n_layers_of(m):
    return len(range(m, DEPTH, N_MIXERS))


def rms_norm(x, g):
    xf = x.astype(jnp.float32)
    y = xf * lax.rsqrt(jnp.mean(xf * xf, axis=-1, keepdims=True) + NORM_EPS)
    return (y * g.astype(jnp.float32)).astype(x.dtype)


def swiglu(x, wg, wu, wd):
    return (jax.nn.silu(x @ wg) * (x @ wu)) @ wd


def alibi_slopes(n):
    return jnp.asarray(2.0 ** (-8.0 * np.arange(1, n + 1) / n), dtype=jnp.float32)


def rope(x, pos):
    dr = x.shape[-1]
    half = dr // 2
    inv = ROPE_THETA ** (-jnp.arange(half, dtype=jnp.float32) / half)
    ang = pos.astype(jnp.float32)[:, None] * inv[None, :]
    cos = jnp.cos(ang)[:, None, :]
    sin = jnp.sin(ang)[:, None, :]
    xf = x.astype(jnp.float32)
    x1, x2 = xf[..., :half], xf[..., half:]
    return jnp.concatenate([x1 * cos - x2 * sin, x1 * sin + x2 * cos], axis=-1).astype(x.dtype)


def banded_attention(q, k, v, w, slopes, dist_scale, n_valid, sink=None):
    N, L, Hk, G, hd = q.shape
    nb = L // w
    qb = q.reshape(N, nb, w, Hk, G, hd)
    pad = ((0, 0), (w, w), (0, 0), (0, 0))
    kp = jnp.pad(k, pad)
    vp = jnp.pad(v, pad)

    def neigh(t):
        return jnp.concatenate([t[:, o * w:o * w + L].reshape(N, nb, w, Hk, hd) for o in range(3)], axis=2)

    kb, vb = neigh(kp), neigh(vp)
    rel = jnp.arange(3 * w)[None, :] - w - jnp.arange(w)[:, None]
    key_pos = jnp.arange(nb)[:, None, None] * w + jnp.arange(3 * w)[None, None, :] - w
    valid = (jnp.abs(rel) <= w)[None] & (key_pos >= 0) & (key_pos < n_valid)
    dist = (dist_scale * jnp.abs(rel)).astype(jnp.float32)
    bias = -slopes.reshape(Hk, G)[:, :, None, None] * dist
    s = jnp.einsum('nbqhgd,nbkhd->nbhgqk', qb, kb, preferred_element_type=jnp.float32) * (hd ** -0.5)
    s = jnp.where(valid[None, :, None, None], s + bias, NEG_INF)
    m = jnp.max(s, axis=-1, keepdims=True)
    if sink is not None:
        sk = sink.reshape(Hk, G)[:, :, None, None].astype(jnp.float32)
        m = jnp.maximum(m, sk)
    p = jnp.exp(s - m)
    denom = jnp.sum(p, axis=-1, keepdims=True)
    if sink is not None:
        denom = denom + jnp.exp(sk - m)
    p = p / denom
    o = jnp.einsum('nbhgqk,nbkhd->nbqhgd', p.astype(vb.dtype), vb, preferred_element_type=jnp.float32)
    lse = (m + jnp.log(denom))[..., 0].transpose(0, 1, 4, 2, 3)
    return o.reshape(N, L, Hk, G, hd), lse.reshape(N, L, Hk, G)


def dense_blocked_attention(q, k, v):
    N, L, Hk, G, dq = q.shape
    dv = v.shape[-1]
    nb = L // Q_BLOCK
    qb = jnp.moveaxis(q.reshape(N, nb, Q_BLOCK, Hk, G, dq), 1, 0)
    scale = dq ** -0.5

    def one_block(qblk):
        s = jnp.einsum('nqhgd,nkhd->nhgqk', qblk, k, preferred_element_type=jnp.float32) * scale
        p = jax.nn.softmax(s, axis=-1)
        return jnp.einsum('nhgqk,nkhd->nqhgd', p.astype(v.dtype), v, preferred_element_type=jnp.float32)

    ob = lax.map(one_block, qb)
    return jnp.moveaxis(ob, 0, 1).reshape(N, L, Hk, G, dv)


def mixer_a(h, wqkv, gq, gk, sink, wo):
    B, L, _ = h.shape
    G = A_HEADS // A_KV_HEADS
    nq, nk = A_HEADS * HEAD_DIM, A_KV_HEADS * HEAD_DIM
    qkv = h @ wqkv
    q = rms_norm(qkv[..., :nq].reshape(B, L, A_KV_HEADS, G, HEAD_DIM), gq)
    k = rms_norm(qkv[..., nq:nq + nk].reshape(B, L, A_KV_HEADS, HEAD_DIM), gk)
    v = qkv[..., nq + nk:].reshape(B, L, A_KV_HEADS, HEAD_DIM)
    o, _ = banded_attention(q, k, v, A_HALF_WINDOW, alibi_slopes(A_HEADS), 1, L, sink)
    return o.reshape(B, L, nq).astype(h.dtype) @ wo


def mixer_b(h, wdq, gcq, wuq, wdkv, gckv, wukv, gq, gk, wo):
    B, L, _ = h.shape
    pos = jnp.arange(L)
    c_q = rms_norm(h @ wdq, gcq)
    q = (c_q @ wuq).reshape(B, L, B_HEADS, B_NOPE + B_ROPE)
    kv_in = h @ wdkv
    c_kv = rms_norm(kv_in[..., :B_KV_LORA], gckv)
    k_rope = jnp.broadcast_to(kv_in[..., None, B_KV_LORA:], (B, L, B_HEADS, B_ROPE))
    kv = (c_kv @ wukv).reshape(B, L, B_HEADS, B_NOPE + B_V)
    k = jnp.concatenate([kv[..., :B_NOPE], k_rope], axis=-1)
    v = kv[..., B_NOPE:]
    q = rms_norm(q, gq)
    k = rms_norm(k, gk)
    q = jnp.concatenate([q[..., :B_NOPE], rope(q[..., B_NOPE:], pos)], axis=-1)
    k = jnp.concatenate([k[..., :B_NOPE], rope(k[..., B_NOPE:], pos)], axis=-1)
    o = dense_blocked_attention(q[:, :, :, None], k, v)
    return o.reshape(B, L, B_HEADS * B_V).astype(h.dtype) @ wo


def mixer_c(h, wqkv, gq, gk, wo):
    B, L, _ = h.shape
    n_groups = len(C_PATTERNS)
    qkv = (h @ wqkv).reshape(B, L, n_groups, 3, C_HEADS, HEAD_DIM)
    slopes = alibi_slopes(C_HEADS)
    outs, lses = [], []
    for g, (window, dil) in enumerate(C_PATTERNS):
        steps = window // (2 * dil)
        sub = L // dil
        sub_p = ((sub + steps - 1) // steps) * steps

        def to_sub(t):
            t = t.reshape(B, sub, dil, C_HEADS, HEAD_DIM).transpose(0, 2, 1, 3, 4)
            t = t.reshape(B * dil, sub, C_HEADS, HEAD_DIM)
            return jnp.pad(t, ((0, 0), (0, sub_p - sub), (0, 0), (0, 0)))

        q = to_sub(rms_norm(qkv[:, :, g, 0], gq))
        k = to_sub(rms_norm(qkv[:, :, g, 1], gk))
        v = to_sub(qkv[:, :, g, 2])
        o, lse = banded_attention(q[:, :, :, None], k, v, steps, slopes, dil, sub)
        o = o[:, :sub, :, 0].reshape(B, dil, sub, C_HEADS, HEAD_DIM).transpose(0, 2, 1, 3, 4)
        lse = lse[:, :sub, :, 0].reshape(B, dil, sub, C_HEADS).transpose(0, 2, 1, 3)
        outs.append(o.reshape(B, L, C_HEADS, HEAD_DIM))
        lses.append(lse.reshape(B, L, C_HEADS))
    wts = jax.nn.softmax(jnp.stack(lses, axis=0), axis=0)
    o = jnp.sum(wts[..., None] * jnp.stack(outs, axis=0), axis=0)
    return o.reshape(B, L, C_HEADS * HEAD_DIM).astype(h.dtype) @ wo


def mixer_d(h, wqkv, gq, gk, wo):
    B, L, _ = h.shape
    G = D_HEADS // D_KV_HEADS
    n_rows = L // GRID_W
    rows = jnp.repeat(jnp.arange(n_rows), GRID_W)
    cols = jnp.tile(jnp.arange(GRID_W), n_rows)
    nq, nk = D_HEADS * HEAD_DIM, D_KV_HEADS * HEAD_DIM
    qkv = h @ wqkv
    q = rms_norm(qkv[..., :nq].reshape(B, L, D_HEADS, HEAD_DIM), gq)
    k = rms_norm(qkv[..., nq:nq + nk].reshape(B, L, D_KV_HEADS, HEAD_DIM), gk)
    v = qkv[..., nq + nk:].reshape(B, L, D_KV_HEADS, HEAD_DIM)
    half = HEAD_DIM // 2

    def axial(t):
        return jnp.concatenate([rope(t[..., :half], rows), rope(t[..., half:], cols)], axis=-1)

    q = axial(q).reshape(B, L, D_KV_HEADS, G, HEAD_DIM)
    k = axial(k)
    o = dense_blocked_attention(q, k, v)
    return o.reshape(B, L, nq).astype(h.dtype) @ wo


def run_trunk(x, p):
    for i in range(DEPTH):
        m, j = i % N_MIXERS, i // N_MIXERS
        x = x + RESIDUAL_HALF * swiglu(rms_norm(x, p['norm_ffn1'][i]), p['ffn1_wg'][i], p['ffn1_wu'][i], p['ffn1_wd'][i])
        h = rms_norm(x, p['norm_mix'][i])
        if m == 0:
            y = mixer_a(h, p['a_wqkv'][j], p['a_gq'][j], p['a_gk'][j], p['a_sink'][j], p['a_wo'][j])
        elif m == 1:
            y = mixer_b(h, p['b_wdq'][j], p['b_gcq'][j], p['b_wuq'][j], p['b_wdkv'][j], p['b_gckv'][j],
                        p['b_wukv'][j], p['b_gq'][j], p['b_gk'][j], p['b_wo'][j])
        elif m == 2:
            y = mixer_c(h, p['c_wqkv'][j], p['c_gq'][j], p['c_gk'][j], p['c_wo'][j])
        else:
            y = mixer_d(h, p['d_wqkv'][j], p['d_gq'][j], p['d_gk'][j], p['d_wo'][j])
        x = x + y
        x = x + RESIDUAL_HALF * swiglu(rms_norm(x, p['norm_ffn2'][i]), p['ffn2_wg'][i], p['ffn2_wu'][i], p['ffn2_wd'][i])
    return x


def setup_inputs(seed: int = 0) -> dict:
    key = jax.random.key(seed)
    counter = [0]

    def nxt():
        counter[0] += 1
        return jax.random.fold_in(key, counter[0])

    def dense(shape):
        return jax.random.normal(nxt(), shape, jnp.float32) * (shape[-2] ** -0.5)

    def gain(shape):
        return 1.0 + 0.02 * jax.random.normal(nxt(), shape, jnp.float32)

    nA, nB, nC, nD = [n_layers_of(m) for m in range(N_MIXERS)]
    hd = HEAD_DIM
    return {
        "x_prompt": jax.random.normal(nxt(), (BATCH, SEQ, D_MODEL), jnp.float32),
        "x_sample": jax.random.normal(nxt(), (DEC_BATCH, DEC_SEQ, D_MODEL), jnp.float32),
        "norm_ffn1": gain((DEPTH, D_MODEL)),
        "ffn1_wg": dense((DEPTH, D_MODEL, D_FF)),
        "ffn1_wu": dense((DEPTH, D_MODEL, D_FF)),
        "ffn1_wd": dense((DEPTH, D_FF, D_MODEL)),
        "norm_mix": gain((DEPTH, D_MODEL)),
        "norm_ffn2": gain((DEPTH, D_MODEL)),
        "ffn2_wg": dense((DEPTH, D_MODEL, D_FF)),
        "ffn2_wu": dense((DEPTH, D_MODEL, D_FF)),
        "ffn2_wd": dense((DEPTH, D_FF, D_MODEL)),
        "a_wqkv": dense((nA, D_MODEL, (A_HEADS + 2 * A_KV_HEADS) * hd)),
        "a_gq": gain((nA, hd)),
        "a_gk": gain((nA, hd)),
        "a_sink": 0.5 * jax.random.normal(nxt(), (nA, A_HEADS), jnp.float32),
        "a_wo": dense((nA, A_HEADS * hd, D_MODEL)),
        "b_wdq": dense((nB, D_MODEL, B_Q_LORA)),
        "b_gcq": gain((nB, B_Q_LORA)),
        "b_wuq": dense((nB, B_Q_LORA, B_HEADS * (B_NOPE + B_ROPE))),
        "b_wdkv": dense((nB, D_MODEL, B_KV_LORA + B_ROPE)),
        "b_gckv": gain((nB, B_KV_LORA)),
        "b_wukv": dense((nB, B_KV_LORA, B_HEADS * (B_NOPE + B_V))),
        "b_gq": gain((nB, B_NOPE + B_ROPE)),
        "b_gk": gain((nB, B_NOPE + B_ROPE)),
        "b_wo": dense((nB, B_HEADS * B_V, D_MODEL)),
        "c_wqkv": dense((nC, D_MODEL, len(C_PATTERNS) * 3 * C_HEADS * hd)),
        "c_gq": gain((nC, hd)),
        "c_gk": gain((nC, hd)),
        "c_wo": dense((nC, C_HEADS * hd, D_MODEL)),
        "d_wqkv": dense((nD, D_MODEL, (D_HEADS + 2 * D_KV_HEADS) * hd)),
        "d_gq": gain((nD, hd)),
        "d_gk": gain((nD, hd)),
        "d_wo": dense((nD, D_HEADS * hd, D_MODEL)),
    }


def reference(x_prompt, x_sample, norm_ffn1, ffn1_wg, ffn1_wu, ffn1_wd, norm_mix, norm_ffn2,
              ffn2_wg, ffn2_wu, ffn2_wd, a_wqkv, a_gq, a_gk, a_sink, a_wo, b_wdq, b_gcq, b_wuq,
              b_wdkv, b_gckv, b_wukv, b_gq, b_gk, b_wo, c_wqkv, c_gq, c_gk, c_wo, d_wqkv, d_gq,
              d_gk, d_wo):
    p = dict(norm_ffn1=norm_ffn1, ffn1_wg=ffn1_wg, ffn1_wu=ffn1_wu, ffn1_wd=ffn1_wd,
             norm_mix=norm_mix, norm_ffn2=norm_ffn2, ffn2_wg=ffn2_wg, ffn2_wu=ffn2_wu,
             ffn2_wd=ffn2_wd, a_wqkv=a_wqkv, a_gq=a_gq, a_gk=a_gk, a_sink=a_sink, a_wo=a_wo,
             b_wdq=b_wdq, b_gcq=b_gcq, b_wuq=b_wuq, b_wdkv=b_wdkv, b_gckv=b_gckv,
             b_wukv=b_wukv, b_gq=b_gq, b_gk=b_gk, b_wo=b_wo, c_wqkv=c_wqkv, c_gq=c_gq,
             c_gk=c_gk, c_wo=c_wo, d_wqkv=d_wqkv, d_gq=d_gq, d_gk=d_gk, d_wo=d_wo)
    y_prompt = run_trunk(x_prompt, p)
    y_sample = run_trunk(x_sample, p)
    return (y_prompt, y_sample)
```

```cpp
#include <hip/hip_runtime.h>
#include <hip/hip_cooperative_groups.h>
#include <cstdio>
#include <cstdint>
namespace cg = cooperative_groups;
namespace pg8 {
#define PG8_LAS __attribute__((address_space(3)))
typedef unsigned short bf16_t;
typedef short bf16x8 __attribute__((ext_vector_type(8)));
typedef float f32x4 __attribute__((ext_vector_type(4)));
typedef unsigned u32x4 __attribute__((ext_vector_type(4)));
constexpr int BM = 256, BK = 64, HALF = 128, HTB = HALF * BK * 2  , STAGE_BYTES = 8 * HTB, NXCD = 8, WGM = 8;

__host__ __device__ __forceinline__ int lds_byte(int r, int c) { const int st = (r >> 4) * 2 + (c >> 5), rr = r & 15, cc = c & 31, ob = rr * 64 + cc * 2; return st * 1024 + (ob ^ (((ob >> 9) & 1) << 5)); }
__host__ __device__ __forceinline__ void stage_rc(int b, int& R, int& C) { const int st = b / 1024, sb = b % 1024, swz = sb ^ (((sb >> 9) & 1) << 5); R = (st >> 1) * 16 + swz / 64; C = (st & 1) * 32 + (swz % 64) / 2; }
__host__ __device__ __forceinline__ int perm32(int rho) { const int n = rho >> 4, i = rho & 15; return 8 * (i >> 2) + 4 * n + (i & 3); }

struct Unit { int pm, pn; };
struct Gemm { const bf16_t* A; const bf16_t* Bt; int M, N, K, lda; };

struct StaticOrder {
    int nM, nN, nwg, G, c;
    __host__ __device__ void init(int M, int N, int G_, int c_) { nM = M / BM; nN = N / BM; nwg = nM * nN; G = G_; c = c_; }
    __host__ __device__ bool next(int i, Unit& u) const {
        const long L = (long)i * G + c; if (L >= nwg) return false;
        int wgid = (int)L; { const int q = nwg / NXCD, r = nwg % NXCD, xcd = wgid % NXCD, off = wgid / NXCD; wgid = (xcd < r ? xcd * (q + 1) : r * (q + 1) + (xcd - r) * q) + off; }
        const int nig = WGM * nN, gid = wgid / nig, fm = gid * WGM, gsz = (nM - fm) < WGM ? (nM - fm) : WGM;
        u.pm = fm + ((wgid % nig) % gsz); u.pn = (wgid % nig) / gsz; return true;
    }
    __device__ __forceinline__ void a_ready(const Unit&) const {}
    __device__ __forceinline__ void done(const Unit&) const {}
};

__device__ __forceinline__ unsigned cvt_pk_bf16(float lo, float hi) { unsigned r; asm volatile("v_cvt_pk_bf16_f32 %0, %1, %2" : "=v"(r) : "v"(lo), "v"(hi)); return r; }
typedef float f32x2 __attribute__((ext_vector_type(2)));
__device__ __forceinline__ float rstd_from(const float* ps, int row, int off4, int n4, float inv_dim, int fq) {
    float s = 0.f;
    if (fq < n4) { const f32x4 v = *((const f32x4*)(ps + (size_t)row * 16) + off4 + fq); s = (v[0] + v[1]) + (v[2] + v[3]); }
    s += __shfl_xor(s, 16); s += __shfl_xor(s, 32);
    return rsqrtf(s * inv_dim + 1e-6f);
}
struct EpiSwiglu {
    static constexpr bool PERM = true, AFTER_DRAIN = false;
    bf16_t* H; const float* ps;
    __device__ __forceinline__ void operator()(const f32x4 (&acc)[2][2][4][2], const Unit& u, int wr, int wc, int fr, int fq) const {
        const int row0 = u.pm * BM + wr * 64 + fr, col0 = u.pn * 128 + wc * 32 + 8 * fq;
#pragma unroll
        for (int ai = 0; ai < 2; ++ai)
#pragma unroll
            for (int m = 0; m < 4; ++m) {
                const int row = row0 + ai * HALF + m * 16;
                const float rs = rstd_from(ps, row, 0, 4, 1.f / 1024.f, fq);
                float hv[8];
#pragma unroll
                for (int n = 0; n < 2; ++n)
#pragma unroll
                    for (int e = 0; e < 4; ++e) { const float gt = acc[ai][0][m][n][e] * rs, up = acc[ai][1][m][n][e] * rs;
                        hv[n * 4 + e] = gt * __builtin_amdgcn_rcpf(1.f + __builtin_amdgcn_exp2f(-1.4426950408889634f * gt)) * up; }
                u32x4 w; w.x = cvt_pk_bf16(hv[0], hv[1]); w.y = cvt_pk_bf16(hv[2], hv[3]); w.z = cvt_pk_bf16(hv[4], hv[5]); w.w = cvt_pk_bf16(hv[6], hv[7]);
                *(u32x4*)(H + (size_t)row * 2816 + col0) = w;
            }
    }
};
struct EpiRes {
    static constexpr bool PERM = true, AFTER_DRAIN = false;
    float* OUT; bf16_t* XB; float* ps; float alpha;
    __device__ __forceinline__ void operator()(const f32x4 (&acc)[2][2][4][2], const Unit& u, int wr, int wc, int fr, int fq) const {
        const int row0 = u.pm * BM + wr * 64 + fr, col0 = u.pn * BM + wc * 32 + 8 * fq;
#pragma unroll
        for (int ai = 0; ai < 2; ++ai)
#pragma unroll
            for (int m = 0; m < 4; ++m) {
                const int row = row0 + ai * HALF + m * 16;
                bf16_t* xb = XB + (size_t)row * 1024 + col0; float ss = 0.f;
#pragma unroll
                for (int bj = 0; bj < 2; ++bj) {
                    const u32x4 xw = *(const u32x4*)(xb + bj * HALF);
                    f32x4 x0, x1;
                    x0[0] = __uint_as_float(xw.x << 16); x0[1] = __uint_as_float(xw.x & 0xffff0000u); x0[2] = __uint_as_float(xw.y << 16); x0[3] = __uint_as_float(xw.y & 0xffff0000u);
                    x1[0] = __uint_as_float(xw.z << 16); x1[1] = __uint_as_float(xw.z & 0xffff0000u); x1[2] = __uint_as_float(xw.w << 16); x1[3] = __uint_as_float(xw.w & 0xffff0000u);
                    x0 = x0 + acc[ai][bj][m][0] * alpha; x1 = x1 + acc[ai][bj][m][1] * alpha;
                    if (OUT) { float* xr = OUT + (size_t)row * 1024 + col0 + bj * HALF; *(f32x4*)xr = x0; *(f32x4*)(xr + 4) = x1; }
                    else {
                        u32x4 w; w.x = cvt_pk_bf16(x0[0], x0[1]); w.y = cvt_pk_bf16(x0[2], x0[3]); w.z = cvt_pk_bf16(x1[0], x1[1]); w.w = cvt_pk_bf16(x1[2], x1[3]);
                        *(u32x4*)(xb + bj * HALF) = w;
                        ss += (x0[0] * x0[0] + x0[1] * x0[1]) + (x0[2] * x0[2] + x0[3] * x0[3]) + (x1[0] * x1[0] + x1[1] * x1[1]) + (x1[2] * x1[2] + x1[3] * x1[3]);
                    }
                }
                if (!OUT) { ss += __shfl_xor(ss, 16); ss += __shfl_xor(ss, 32); if (fq == 0) ps[(size_t)row * 16 + u.pn * 4 + wc] = ss; }
            }
    }
};
struct EpiBf16 {
    static constexpr bool PERM = true, AFTER_DRAIN = false;
    bf16_t* O; bf16_t* O2; int ldc; const float* ps_in; int off4, n4; float inv_dim; float* ps_out; int mode; const float* gq; const float* gk; int nq, nke;
    __device__ __forceinline__ void operator()(const f32x4 (&acc)[2][2][4][2], const Unit& u, int wr, int wc, int fr, int fq) const {
        const int row0 = u.pm * BM + wr * 64 + fr, col0 = u.pn * BM + wc * 32 + 8 * fq;
        if (mode == 3) {
            const int t6 = u.pn % 6, ttype = t6 < nq ? 0 : (t6 < nke ? 1 : 2);
            float gv[2][8];
#pragma unroll
            for (int bj = 0; bj < 2; ++bj)
#pragma unroll
                for (int j = 0; j < 8; ++j) gv[bj][j] = ttype == 0 ? gq[32 * bj + 8 * fq + j] * (0.125f * 1.4426950408889634f) : (ttype == 1 ? gk[32 * bj + 8 * fq + j] : 1.f);
            const int colo = u.pn * BM + 64 * wc + 8 * fq;
#pragma unroll
            for (int ai = 0; ai < 2; ++ai)
#pragma unroll
                for (int m = 0; m < 4; ++m) {
                    const int row = row0 + ai * HALF + m * 16;
                    const float rs = rstd_from(ps_in, row, off4, n4, inv_dim, fq);
                    f32x4 v[2][2]; float ss = 0.f;
#pragma unroll
                    for (int bj = 0; bj < 2; ++bj) { v[bj][0] = acc[ai][bj][m][0] * rs; v[bj][1] = acc[ai][bj][m][1] * rs;
                        ss += (v[bj][0][0] * v[bj][0][0] + v[bj][0][1] * v[bj][0][1]) + (v[bj][0][2] * v[bj][0][2] + v[bj][0][3] * v[bj][0][3]) + (v[bj][1][0] * v[bj][1][0] + v[bj][1][1] * v[bj][1][1]) + (v[bj][1][2] * v[bj][1][2] + v[bj][1][3] * v[bj][1][3]); }
                    ss += __shfl_xor(ss, 16); ss += __shfl_xor(ss, 32);
                    const float rh = ttype < 2 ? rsqrtf(ss * (1.f / 64.f) + 1e-6f) : 1.f;
#pragma unroll
                    for (int bj = 0; bj < 2; ++bj) {
                        u32x4 w; w.x = cvt_pk_bf16(v[bj][0][0] * rh * gv[bj][0], v[bj][0][1] * rh * gv[bj][1]); w.y = cvt_pk_bf16(v[bj][0][2] * rh * gv[bj][2], v[bj][0][3] * rh * gv[bj][3]);
                        w.z = cvt_pk_bf16(v[bj][1][0] * rh * gv[bj][4], v[bj][1][1] * rh * gv[bj][5]); w.w = cvt_pk_bf16(v[bj][1][2] * rh * gv[bj][6], v[bj][1][3] * rh * gv[bj][7]);
                        *(u32x4*)(O + (size_t)row * ldc + colo + 32 * bj) = w;
                    }
                }
            return;
        }
#pragma unroll
        for (int ai = 0; ai < 2; ++ai)
#pragma unroll
            for (int m = 0; m < 4; ++m) {
                const int row = row0 + ai * HALF + m * 16;
                const float rs = rstd_from(ps_in, row, off4, n4, inv_dim, fq); float ss = 0.f;
#pragma unroll
                for (int bj = 0; bj < 2; ++bj) {
                    const f32x4 v0 = acc[ai][bj][m][0] * rs, v1 = acc[ai][bj][m][1] * rs; const int colg = col0 + bj * HALF;
                    bf16_t* dst;
                    if (mode == 2) { const int hh = colg >> 7, d = colg & 127; dst = d < 64 ? O + (size_t)row * 1536 + hh * 96 + d : O2 + (size_t)row * 1024 + hh * 64 + (d - 64); }
                    else dst = O + (size_t)row * ldc + colg;
                    u32x4 w; w.x = cvt_pk_bf16(v0[0], v0[1]); w.y = cvt_pk_bf16(v0[2], v0[3]); w.z = cvt_pk_bf16(v1[0], v1[1]); w.w = cvt_pk_bf16(v1[2], v1[3]);
                    *(u32x4*)dst = w;
                    ss += (v0[0] * v0[0] + v0[1] * v0[1]) + (v0[2] * v0[2] + v0[3] * v0[3]) + (v1[0] * v1[0] + v1[1] * v1[1]) + (v1[2] * v1[2] + v1[3] * v1[3]);
                }
                if (mode == 1) { ss += __shfl_xor(ss, 16); ss += __shfl_xor(ss, 32); if (fq == 0) ps_out[(size_t)row * 16 + u.pn * 4 + wc] = ss; }
            }
    }
};

template <class Epi, class Sched, bool ALIGN_EPI = false, bool SP2 = false>
__device__ __forceinline__ void gemm_phase(PG8_LAS unsigned char* lds, const Gemm g, const Sched& S, const Epi& E) {
    int tid_o = threadIdx.x; asm volatile("" : "+v"(tid_o));
    const int tid = tid_o, wid = __builtin_amdgcn_readfirstlane(tid >> 6), lane = tid & 63, wr = wid >> 2, wc = wid & 3, fr = lane & 15, fq = lane >> 4;
    const int K = g.K, nt = K / BK;
    unsigned voffA[2], voffB[2];
#pragma unroll
    for (int i = 0; i < 2; ++i) { int R, C; stage_rc(tid * 16 + i * 8192, R, C); const int Rb = Epi::PERM ? ((R & ~31) + perm32(R & 31)) : R;
        voffA[i] = (unsigned)(R * g.lda + C) * 2u; voffB[i] = (unsigned)(Rb * K + C) * 2u; }
    const size_t kstep = (size_t)(BK * 2);
    const size_t hstep = (size_t)HALF * K * 2;
    const size_t tstep = 2 * hstep; const size_t hstepA = (size_t)HALF * g.lda * 2, tstepA = 2 * hstepA;
    const unsigned ldsw = (unsigned)wid * 1024u;
    const int aoff = lds_byte(wr * 64 + fr, fq * 8), boff = lds_byte(wc * 32 + fr, fq * 8);
#define PG8_SA(b, h) (((b) * 2 + (h)) * HTB)
#define PG8_SB(b, h) ((4 + (b) * 2 + (h)) * HTB)
#define PG8_STAGE(bufoff, gbase, voff) do { _Pragma("unroll") for (int _i = 0; _i < 2; ++_i) \
        __builtin_amdgcn_global_load_lds((const unsigned*)((const char*)(gbase) + (voff)[_i]), (PG8_LAS unsigned*)(lds + (bufoff) + ldsw + _i * 8192), 16, 0, 0); } while (0)
#define PG8_LDA(dst, b, h) do { _Pragma("unroll") for (int m = 0; m < 4; ++m) _Pragma("unroll") for (int k = 0; k < 2; ++k) dst[m][k] = *(const PG8_LAS bf16x8*)(lds + PG8_SA(b, h) + aoff + m * 2048 + k * 1024); } while (0)
#define PG8_LDB(dst, b, h) do { _Pragma("unroll") for (int n = 0; n < 2; ++n) _Pragma("unroll") for (int k = 0; k < 2; ++k) dst[n][k] = *(const PG8_LAS bf16x8*)(lds + PG8_SB(b, h) + boff + n * 2048 + k * 1024); } while (0)
#define PG8_MMA(ai, bj, At, Bt) do { __builtin_amdgcn_s_setprio(1); _Pragma("unroll") for (int m = 0; m < 4; ++m) _Pragma("unroll") for (int n = 0; n < 2; ++n) _Pragma("unroll") for (int k = 0; k < 2; ++k) \
        acc[ai][bj][m][n] = __builtin_amdgcn_mfma_f32_16x16x32_bf16(Bt[n][k], At[m][k], acc[ai][bj][m][n], 0, 0, 0); __builtin_amdgcn_s_setprio(0); } while (0)
#define PG8_WAIT_V(n) asm volatile("s_waitcnt vmcnt(" #n ")" ::: "memory")
#define PG8_WAIT_L(n) asm volatile("s_waitcnt lgkmcnt(" #n ")" ::: "memory")
#define PG8_BAR __builtin_amdgcn_s_barrier()
#define PG8_SCHED __builtin_amdgcn_sched_barrier(0)
    Unit cur, nxt; int ui = 0;
    if (!S.next(0, cur)) return;
    f32x4 acc[2][2][4][2];
#pragma unroll
    for (int a = 0; a < 2; ++a)
#pragma unroll
        for (int b = 0; b < 2; ++b)
#pragma unroll
            for (int m = 0; m < 4; ++m)
#pragma unroll
                for (int n = 0; n < 2; ++n) acc[a][b][m][n] = (f32x4){0.f, 0.f, 0.f, 0.f};
    bf16x8 At[4][2], B0[2][2], B1[2][2];
    const char* cA = (const char*)g.A + (size_t)cur.pm * tstepA; const char* cB = (const char*)g.Bt + (size_t)cur.pn * tstep;
    S.a_ready(cur);
    if constexpr (SP2) {
        PG8_STAGE(PG8_SB(0, 0), cB, voffB); PG8_STAGE(PG8_SB(0, 1), cB + hstep, voffB); PG8_STAGE(PG8_SA(0, 0), cA, voffA); PG8_STAGE(PG8_SA(0, 1), cA + hstepA, voffA);
        if (wr == 1) PG8_BAR;
        PG8_WAIT_V(2); PG8_BAR;
        PG8_STAGE(PG8_SB(1, 0), cB + kstep, voffB); PG8_STAGE(PG8_SA(1, 0), cA + kstep, voffA); PG8_STAGE(PG8_SB(1, 1), cB + hstep + kstep, voffB);
        PG8_WAIT_V(6); PG8_BAR;
    } else {
        PG8_STAGE(PG8_SB(0, 0), cB, voffB); PG8_STAGE(PG8_SA(0, 0), cA, voffA); PG8_STAGE(PG8_SB(0, 1), cB + hstep, voffB); PG8_STAGE(PG8_SA(0, 1), cA + hstepA, voffA);
        if (wr == 1) PG8_BAR;
        PG8_WAIT_V(4); PG8_BAR;
        PG8_STAGE(PG8_SB(1, 0), cB + kstep, voffB); PG8_STAGE(PG8_SA(1, 0), cA + kstep, voffA); PG8_STAGE(PG8_SB(1, 1), cB + hstep + kstep, voffB);
        PG8_WAIT_V(6); PG8_BAR;
    }
    for (;;) {
        const bool has_next = S.next(ui + 1, nxt);
        const char* nA = has_next ? (const char*)g.A + (size_t)nxt.pm * tstepA : cA; const char* nB = has_next ? (const char*)g.Bt + (size_t)nxt.pn * tstep : cB;
        for (int t = 0; t < nt; t += 2) {
            const bool last = (t == nt - 2);
            const char* a1 = cA + (size_t)(t + 1) * kstep;
            const char* a2 = last ? nA : cA + (size_t)(t + 2) * kstep; const char* b2 = last ? nB : cB + (size_t)(t + 2) * kstep;
            const char* a3 = a2 + kstep; const char* b3 = b2 + kstep;
            if (last && has_next) S.a_ready(nxt);
            if constexpr (SP2) {
            PG8_LDB(B0, 0, 0); PG8_LDB(B1, 0, 1); PG8_SCHED; PG8_LDA(At, 0, 0); PG8_STAGE(PG8_SA(1, 1), a1 + hstepA, voffA);
            PG8_WAIT_V(8); PG8_WAIT_L(0); PG8_BAR; PG8_MMA(0, 0, At, B0); PG8_MMA(0, 1, At, B1); PG8_BAR; PG8_SCHED;
            PG8_LDA(At, 0, 1); PG8_STAGE(PG8_SB(0, 0), b2, voffB); PG8_STAGE(PG8_SB(0, 1), b2 + hstep, voffB); PG8_STAGE(PG8_SA(0, 0), a2, voffA);
            PG8_WAIT_V(8); PG8_WAIT_L(0); PG8_BAR; PG8_MMA(1, 0, At, B0); PG8_MMA(1, 1, At, B1); PG8_BAR; PG8_SCHED;
            PG8_LDB(B0, 1, 0); PG8_LDB(B1, 1, 1); PG8_SCHED; PG8_LDA(At, 1, 0); PG8_STAGE(PG8_SA(0, 1), a2 + hstepA, voffA);
            PG8_WAIT_V(8); PG8_WAIT_L(0); PG8_BAR; PG8_MMA(0, 0, At, B0); PG8_MMA(0, 1, At, B1); PG8_BAR; PG8_SCHED;
            PG8_LDA(At, 1, 1); PG8_STAGE(PG8_SB(1, 0), b3, voffB); PG8_STAGE(PG8_SB(1, 1), b3 + hstep, voffB); PG8_STAGE(PG8_SA(1, 0), a3, voffA);
            PG8_WAIT_V(8); PG8_WAIT_L(0); PG8_BAR; PG8_MMA(1, 0, At, B0); PG8_MMA(1, 1, At, B1); PG8_BAR; PG8_SCHED;
            } else {
            PG8_LDB(B0, 0, 0); PG8_SCHED; PG8_LDA(At, 0, 0); PG8_STAGE(PG8_SA(1, 1), a1 + hstepA, voffA);
            PG8_WAIT_L(8); PG8_BAR; PG8_WAIT_L(0); PG8_MMA(0, 0, At, B0); PG8_BAR; PG8_SCHED;
            PG8_LDB(B1, 0, 1); PG8_STAGE(PG8_SB(0, 0), b2, voffB);
            PG8_BAR; PG8_WAIT_L(0); PG8_MMA(0, 1, At, B1); PG8_BAR;
            PG8_LDA(At, 0, 1); PG8_STAGE(PG8_SA(0, 0), a2, voffA);
            PG8_BAR; PG8_WAIT_L(0); PG8_MMA(1, 0, At, B0); PG8_BAR; PG8_SCHED;
            PG8_STAGE(PG8_SB(0, 1), b2 + hstep, voffB);
            PG8_WAIT_V(6); PG8_BAR; PG8_MMA(1, 1, At, B1); PG8_BAR;
            PG8_LDB(B0, 1, 0); PG8_SCHED; PG8_LDA(At, 1, 0); PG8_STAGE(PG8_SA(0, 1), a2 + hstepA, voffA);
            PG8_WAIT_L(8); PG8_BAR; PG8_WAIT_L(0); PG8_MMA(0, 0, At, B0); PG8_BAR; PG8_SCHED;
            PG8_LDB(B1, 1, 1); PG8_STAGE(PG8_SB(1, 0), b3, voffB);
            PG8_BAR; PG8_WAIT_L(0); PG8_MMA(0, 1, At, B1); PG8_BAR;
            PG8_LDA(At, 1, 1); PG8_STAGE(PG8_SA(1, 0), a3, voffA);
            PG8_BAR; PG8_WAIT_L(0); PG8_MMA(1, 0, At, B0); PG8_BAR; PG8_SCHED;
            PG8_STAGE(PG8_SB(1, 1), b3 + hstep, voffB);
            PG8_WAIT_V(6); PG8_BAR; PG8_MMA(1, 1, At, B1); PG8_BAR;
            }
        }
        if constexpr (ALIGN_EPI) { if (wr == 0) PG8_BAR; }
        if constexpr (!Epi::AFTER_DRAIN) { E(acc, cur, wr, wc, fr, fq); S.done(cur); }
        if (!has_next) break;
#pragma unroll
        for (int a = 0; a < 2; ++a)
#pragma unroll
            for (int b = 0; b < 2; ++b)
#pragma unroll
                for (int m = 0; m < 4; ++m)
#pragma unroll
                    for (int n = 0; n < 2; ++n) acc[a][b][m][n] = (f32x4){0.f, 0.f, 0.f, 0.f};
        cur = nxt; cA = nA; cB = nB; ++ui;
        if constexpr (ALIGN_EPI) { if (wr == 1) PG8_BAR; }
    }
    PG8_WAIT_V(0);
    if constexpr (!ALIGN_EPI) { if (wr == 0) PG8_BAR; }
    PG8_BAR;
    if constexpr (Epi::AFTER_DRAIN) { E.fused(acc, cur, wr, wc, fr, fq, lds, wid, lane); S.done(cur); }
#undef PG8_SA
#undef PG8_SB
#undef PG8_STAGE
#undef PG8_LDA
#undef PG8_LDB
#undef PG8_MMA
#undef PG8_WAIT_V
#undef PG8_WAIT_L
#undef PG8_BAR
#undef PG8_SCHED
}
}
namespace att {
using pg8::bf16_t; using pg8::bf16x8; using pg8::f32x4; using pg8::u32x4;
typedef float f32x16 __attribute__((ext_vector_type(16)));
typedef short s16x4 __attribute__((ext_vector_type(4)));
typedef float f32x2_t __attribute__((ext_vector_type(2))); typedef __bf16 bf16x2_t __attribute__((ext_vector_type(2)));
#define ALAS __attribute__((address_space(3)))
constexpr float LOG2E = 1.4426950408889634f, LN2 = 0.6931471805599453f;
__device__ __forceinline__ unsigned cvtpk(float lo, float hi) { f32x2_t v = {lo, hi}; bf16x2_t b = __builtin_convertvector(v, bf16x2_t); return __builtin_bit_cast(unsigned, b); }
__device__ __forceinline__ float fadd_s(float a, float b) { float r; asm("v_add_f32_e32 %0, %1, %2" : "=v"(r) : "v"(a), "v"(b)); return r; }
__device__ __forceinline__ int crow(int i, int h) { return (i & 3) + 8 * (i >> 2) + 4 * h; }
__device__ __forceinline__ s16x4 vtr(const ALAS unsigned char* p) { return __builtin_bit_cast(s16x4, __builtin_amdgcn_ds_read_tr16_b64_v4i16((ALAS s16x4*)p)); }
#define AMFMA(a, b, c) __builtin_amdgcn_mfma_f32_32x32x16_bf16((a), (b), (c), 0, 0, 0)

struct AU {
    const bf16_t* Q; const bf16_t* K; const bf16_t* V; bf16_t* O; float* lse; const float* sink;
    long qrs, krs, vrs, ors, lrs;
    int q0, nsub, wph, qhs, ohs, band, hq0; float sl_scale, sl_exp; int r2;
};

__device__ __forceinline__ void attn_unit_r2(const AU& u, ALAS unsigned char* lds, float mb2) {
    constexpr int KP = 144, VP = 144, KBUF = 64 * KP, VBUF = 64 * VP, V_OFF = 2 * KBUF;
    int tid_o = threadIdx.x; asm volatile("" : "+v"(tid_o));
    const int tid = tid_o, lane = tid & 63, wid = __builtin_amdgcn_readfirstlane(tid >> 6), r = lane & 31, h = lane >> 5;
    const int hl = wid / u.wph, qs = u.q0 + 64 * (wid % u.wph);
    bf16x8 qa[4], qb[4];
    { const bf16_t* qp = u.Q + (size_t)hl * u.qhs + (size_t)(qs + r) * u.qrs + h * 8;
#pragma unroll
      for (int d0 = 0; d0 < 4; ++d0) { qa[d0] = *(const bf16x8*)(qp + d0 * 16); qb[d0] = *(const bf16x8*)(qp + (size_t)32 * u.qrs + d0 * 16); } }
    const int NT = u.nsub >> 6;
    const int kr0 = tid >> 3, kc0 = tid & 7;
    const bf16_t* kg0 = u.K + (size_t)kr0 * u.krs + kc0 * 8; const bf16_t* vg = u.V + (size_t)kr0 * u.vrs + kc0 * 8;
    const int kl0 = kr0 * KP + kc0 * 16, vl = V_OFF + kr0 * VP + kc0 * 16;
    f32x16 oa0, oa1, ob0, ob1, negm;
#pragma unroll
    for (int i = 0; i < 16; ++i) { oa0[i] = 0.f; oa1[i] = 0.f; ob0[i] = 0.f; ob1[i] = 0.f; negm[i] = -mb2; }
    float la = 0.f, lb = 0.f;
    u32x4 rk = *(const u32x4*)kg0, rv = *(const u32x4*)vg;
    *(ALAS u32x4*)(lds + kl0) = rk; *(ALAS u32x4*)(lds + vl) = rv;
    __syncthreads();
    for (int t = 0; t < NT; ++t) {
        const int cur = t & 1;
        if (t + 1 < NT) { const size_t ro = (size_t)(t + 1) * 64; rk = *(const u32x4*)(kg0 + ro * u.krs); rv = *(const u32x4*)(vg + ro * u.vrs); }
        {
            const ALAS unsigned char* kb = lds + cur * KBUF + r * KP + h * 16;
            const ALAS unsigned char* vb = lds + V_OFF + cur * VBUF + (4 * h + ((lane & 15) >> 2)) * VP + ((lane >> 4) & 1) * 32 + (lane & 3) * 8;
            f32x16 Sa0 = negm, Sa1 = negm, Sb0 = negm, Sb1 = negm;
#pragma unroll
            for (int d0 = 0; d0 < 4; ++d0) {
                const bf16x8 k0 = *(const ALAS bf16x8*)(kb + d0 * 32), k1 = *(const ALAS bf16x8*)(kb + 32 * KP + d0 * 32);
                Sa0 = AMFMA(k0, qa[d0], Sa0); Sa1 = AMFMA(k1, qa[d0], Sa1); Sb0 = AMFMA(k0, qb[d0], Sb0); Sb1 = AMFMA(k1, qb[d0], Sb1);
            }
            bf16x8 paa[4], pab[4];
#define R2_SOFT(S0_, S1_, PA_, L_) do { float s0_ = 0.f, s1_ = 0.f; \
                _Pragma("unroll") for (int i = 0; i < 16; ++i) { S0_[i] = __builtin_amdgcn_exp2f(S0_[i]); S1_[i] = __builtin_amdgcn_exp2f(S1_[i]); } \
                __builtin_amdgcn_sched_barrier(0);     \
                _Pragma("unroll") for (int i = 0; i < 16; ++i) { s0_ += S0_[i]; s1_ += S1_[i]; } \
                L_ += s0_ + s1_; u32x4 w_; \
                w_.x = cvtpk(S0_[0], S0_[1]); w_.y = cvtpk(S0_[2], S0_[3]); w_.z = cvtpk(S0_[4], S0_[5]); w_.w = cvtpk(S0_[6], S0_[7]); PA_[0] = __builtin_bit_cast(bf16x8, w_); \
                w_.x = cvtpk(S0_[8], S0_[9]); w_.y = cvtpk(S0_[10], S0_[11]); w_.z = cvtpk(S0_[12], S0_[13]); w_.w = cvtpk(S0_[14], S0_[15]); PA_[1] = __builtin_bit_cast(bf16x8, w_); \
                w_.x = cvtpk(S1_[0], S1_[1]); w_.y = cvtpk(S1_[2], S1_[3]); w_.z = cvtpk(S1_[4], S1_[5]); w_.w = cvtpk(S1_[6], S1_[7]); PA_[2] = __builtin_bit_cast(bf16x8, w_); \
                w_.x = cvtpk(S1_[8], S1_[9]); w_.y = cvtpk(S1_[10], S1_[11]); w_.z = cvtpk(S1_[12], S1_[13]); w_.w = cvtpk(S1_[14], S1_[15]); PA_[3] = __builtin_bit_cast(bf16x8, w_); } while (0)
            R2_SOFT(Sa0, Sa1, paa, la);
            R2_SOFT(Sb0, Sb1, pab, lb);
#undef R2_SOFT
#pragma unroll
            for (int ks = 0; ks < 4; ++ks) {
                const s16x4 lo0 = vtr(vb + ks * 16 * VP), hi0 = vtr(vb + (ks * 16 + 8) * VP), lo1 = vtr(vb + ks * 16 * VP + 64), hi1 = vtr(vb + (ks * 16 + 8) * VP + 64);
                const bf16x8 vf0 = __builtin_shufflevector(lo0, hi0, 0, 1, 2, 3, 4, 5, 6, 7), vf1 = __builtin_shufflevector(lo1, hi1, 0, 1, 2, 3, 4, 5, 6, 7);
                oa0 = AMFMA(paa[ks], vf0, oa0); oa1 = AMFMA(paa[ks], vf1, oa1); ob0 = AMFMA(pab[ks], vf0, ob0); ob1 = AMFMA(pab[ks], vf1, ob1);
            }
        }
        if (t + 1 < NT) { *(ALAS u32x4*)(lds + (cur ^ 1) * KBUF + kl0) = rk; *(ALAS u32x4*)(lds + (cur ^ 1) * VBUF + vl) = rv; }
        __syncthreads();
    }
    la += __shfl_xor(la, 32); lb += __shfl_xor(lb, 32);
    const float ia = 1.f / la, ib = 1.f / lb;
    bf16_t* op = u.O + (size_t)hl * u.ohs + r;
#pragma unroll
    for (int i = 0; i < 16; ++i) { const int qi = crow(i, h); const float fa = __shfl(ia, qi), fb = __shfl(ib, qi);
        bf16_t* ra = op + (size_t)(qs + qi) * u.ors; bf16_t* rb = op + (size_t)(qs + 32 + qi) * u.ors;
        ra[0] = (bf16_t)(cvtpk(oa0[i] * fa, 0.f) & 0xffffu); ra[32] = (bf16_t)(cvtpk(oa1[i] * fa, 0.f) & 0xffffu);
        rb[0] = (bf16_t)(cvtpk(ob0[i] * fb, 0.f) & 0xffffu); rb[32] = (bf16_t)(cvtpk(ob1[i] * fb, 0.f) & 0xffffu);
        if ((i & 3) == 3) asm volatile("s_waitcnt vmcnt(0)" ::: "memory"); }
}

__device__ __forceinline__ void attn_unit_r2b(const AU& u, ALAS unsigned char* lds, float mb2) {
    constexpr int KP = 208, VP = 144, KBUF = 64 * KP, VBUF = 64 * VP, V_OFF = 2 * KBUF, QB_OFF = V_OFF + 2 * VBUF;
    int tid_o = threadIdx.x; asm volatile("" : "+v"(tid_o));
    const int tid = tid_o, lane = tid & 63, wid = __builtin_amdgcn_readfirstlane(tid >> 6), r = lane & 31, h = lane >> 5;
    const int qs = u.q0 + 64 * wid;
    bf16x8 qa[6];
    ALAS unsigned char* qbl = lds + QB_OFF + wid * 6144 + lane * 16;
    { const bf16_t* qp = u.Q + (size_t)(qs + r) * u.qrs + h * 8;
#pragma unroll
      for (int d0 = 0; d0 < 6; ++d0) { qa[d0] = *(const bf16x8*)(qp + d0 * 16); const bf16x8 t_ = *(const bf16x8*)(qp + (size_t)32 * u.qrs + d0 * 16); *(ALAS bf16x8*)(qbl + d0 * 1024) = t_; } }
    const int NT = u.nsub >> 6;
    const int kr0 = tid / 12, kc0 = tid - kr0 * 12, c1 = tid + 512, kr1 = c1 / 12, kc1 = c1 - kr1 * 12, vr_ = tid >> 3, vc_ = tid & 7;
    const bool k2 = tid < 256;
    const bf16_t* kg0 = u.K + (size_t)kr0 * u.krs + kc0 * 8; const bf16_t* kg1 = u.K + (size_t)kr1 * u.krs + kc1 * 8; const bf16_t* vg = u.V + (size_t)vr_ * u.vrs + vc_ * 8;
    const int kl0 = kr0 * KP + kc0 * 16, kl1 = kr1 * KP + kc1 * 16, vl = V_OFF + vr_ * VP + vc_ * 16;
    f32x16 oa0, oa1, ob0, ob1;
#pragma unroll
    for (int i = 0; i < 16; ++i) { oa0[i] = 0.f; oa1[i] = 0.f; ob0[i] = 0.f; ob1[i] = 0.f; }
    float la = 0.f, lb = 0.f;
    u32x4 rk0 = *(const u32x4*)kg0, rk1 = (u32x4){0u, 0u, 0u, 0u}, rv = *(const u32x4*)vg;
    if (k2) rk1 = *(const u32x4*)kg1;
    *(ALAS u32x4*)(lds + kl0) = rk0; if (k2) *(ALAS u32x4*)(lds + kl1) = rk1; *(ALAS u32x4*)(lds + vl) = rv;
    __syncthreads();
    for (int t = 0; t < NT; ++t) {
        const int cur = t & 1;
        if (t + 1 < NT) { const size_t ro = (size_t)(t + 1) * 64; rk0 = *(const u32x4*)(kg0 + ro * u.krs); if (k2) rk1 = *(const u32x4*)(kg1 + ro * u.krs); rv = *(const u32x4*)(vg + ro * u.vrs); }
        {
            const ALAS unsigned char* kb = lds + cur * KBUF + r * KP + h * 16;
            const ALAS unsigned char* vb = lds + V_OFF + cur * VBUF + (4 * h + ((lane & 15) >> 2)) * VP + ((lane >> 4) & 1) * 32 + (lane & 3) * 8;
            bf16x8 paa[4], pab[4];
            f32x16 Sa0, Sa1, Sb0, Sb1;
#pragma unroll
            for (int i = 0; i < 16; ++i) { Sa0[i] = 0.f; Sa1[i] = 0.f; Sb0[i] = 0.f; Sb1[i] = 0.f; }
#pragma unroll
            for (int d0 = 0; d0 < 6; ++d0) {
                const bf16x8 k0 = *(const ALAS bf16x8*)(kb + d0 * 32), k1 = *(const ALAS bf16x8*)(kb + 32 * KP + d0 * 32); const bf16x8 qbv = *(const ALAS bf16x8*)(qbl + d0 * 1024);
                Sa0 = AMFMA(k0, qa[d0], Sa0); Sa1 = AMFMA(k1, qa[d0], Sa1); Sb0 = AMFMA(k0, qbv, Sb0); Sb1 = AMFMA(k1, qbv, Sb1);
                if (d0 & 1) __builtin_amdgcn_sched_barrier(0);
            }
#define R2B_SOFT(S0_, S1_, PA_, L_) do { float s0_ = 0.f, s1_ = 0.f; \
                _Pragma("unroll") for (int i = 0; i < 16; ++i) { S0_[i] = __builtin_amdgcn_exp2f(S0_[i] - mb2); S1_[i] = __builtin_amdgcn_exp2f(S1_[i] - mb2); } \
                _Pragma("unroll") for (int i = 0; i < 16; ++i) { s0_ += S0_[i]; s1_ += S1_[i]; } \
                L_ += s0_ + s1_; u32x4 w_; \
                w_.x = cvtpk(S0_[0], S0_[1]); w_.y = cvtpk(S0_[2], S0_[3]); w_.z = cvtpk(S0_[4], S0_[5]); w_.w = cvtpk(S0_[6], S0_[7]); PA_[0] = __builtin_bit_cast(bf16x8, w_); \
                w_.x = cvtpk(S0_[8], S0_[9]); w_.y = cvtpk(S0_[10], S0_[11]); w_.z = cvtpk(S0_[12], S0_[13]); w_.w = cvtpk(S0_[14], S0_[15]); PA_[1] = __builtin_bit_cast(bf16x8, w_); \
                w_.x = cvtpk(S1_[0], S1_[1]); w_.y = cvtpk(S1_[2], S1_[3]); w_.z = cvtpk(S1_[4], S1_[5]); w_.w = cvtpk(S1_[6], S1_[7]); PA_[2] = __builtin_bit_cast(bf16x8, w_); \
                w_.x = cvtpk(S1_[8], S1_[9]); w_.y = cvtpk(S1_[10], S1_[11]); w_.z = cvtpk(S1_[12], S1_[13]); w_.w = cvtpk(S1_[14], S1_[15]); PA_[3] = __builtin_bit_cast(bf16x8, w_); } while (0)
            R2B_SOFT(Sa0, Sa1, paa, la);
            R2B_SOFT(Sb0, Sb1, pab, lb);
#undef R2B_SOFT
#pragma unroll
            for (int ks = 0; ks < 4; ++ks) {
                const s16x4 lo0 = vtr(vb + ks * 16 * VP), hi0 = vtr(vb + (ks * 16 + 8) * VP), lo1 = vtr(vb + ks * 16 * VP + 64), hi1 = vtr(vb + (ks * 16 + 8) * VP + 64);
                const bf16x8 vf0 = __builtin_shufflevector(lo0, hi0, 0, 1, 2, 3, 4, 5, 6, 7), vf1 = __builtin_shufflevector(lo1, hi1, 0, 1, 2, 3, 4, 5, 6, 7);
                oa0 = AMFMA(paa[ks], vf0, oa0); oa1 = AMFMA(paa[ks], vf1, oa1); ob0 = AMFMA(pab[ks], vf0, ob0); ob1 = AMFMA(pab[ks], vf1, ob1);
            }
        }
        if (t + 1 < NT) { *(ALAS u32x4*)(lds + (cur ^ 1) * KBUF + kl0) = rk0; if (k2) *(ALAS u32x4*)(lds + (cur ^ 1) * KBUF + kl1) = rk1; *(ALAS u32x4*)(lds + (cur ^ 1) * VBUF + vl) = rv; }
        __syncthreads();
    }
    la += __shfl_xor(la, 32); lb += __shfl_xor(lb, 32);
    const float ia = 1.f / la, ib = 1.f / lb;
    bf16_t* op = u.O + r;
#pragma unroll
    for (int i = 0; i < 16; ++i) { const int qi = crow(i, h); const float fa = __shfl(ia, qi), fb = __shfl(ib, qi);
        bf16_t* ra = op + (size_t)(qs + qi) * u.ors; bf16_t* rb = op + (size_t)(qs + 32 + qi) * u.ors;
        ra[0] = (bf16_t)(cvtpk(oa0[i] * fa, 0.f) & 0xffffu); ra[32] = (bf16_t)(cvtpk(oa1[i] * fa, 0.f) & 0xffffu);
        rb[0] = (bf16_t)(cvtpk(ob0[i] * fb, 0.f) & 0xffffu); rb[32] = (bf16_t)(cvtpk(ob1[i] * fb, 0.f) & 0xffffu);
        if ((i & 3) == 3) asm volatile("s_waitcnt vmcnt(0)" ::: "memory"); }
}

template <int DQ> __device__ __forceinline__ void attn_unit(const AU& u, ALAS unsigned char* lds, float mb2) {
    if constexpr (DQ == 64) { if (u.r2) { attn_unit_r2(u, lds, mb2); return; } }
    if constexpr (DQ == 96) { if (u.r2) { attn_unit_r2b(u, lds, mb2); return; } }
    constexpr int KP = DQ * 2 + 16, VP = 144, NF = DQ / 16, CPR = DQ / 8, KBUF = 64 * KP, VBUF = 64 * VP, V_OFF = 2 * KBUF;
    int tid_o = threadIdx.x; asm volatile("" : "+v"(tid_o));
    const int tid = tid_o, lane = tid & 63, wid = __builtin_amdgcn_readfirstlane(tid >> 6), r = lane & 31, h = lane >> 5;
    const int hl = wid / u.wph, qs = u.q0 + 32 * (wid % u.wph);
    const bool wact = qs < u.nsub;
    bf16x8 qf[NF];
#pragma unroll
    for (int d0 = 0; d0 < NF; ++d0) qf[d0] = (bf16x8){0, 0, 0, 0, 0, 0, 0, 0};
    if (wact) { const bf16_t* qp = u.Q + (size_t)hl * u.qhs + (size_t)(qs + r) * u.qrs + h * 8;
#pragma unroll
        for (int d0 = 0; d0 < NF; ++d0) qf[d0] = *(const bf16x8*)(qp + d0 * 16); }
    const int RU = 32 * u.wph;
    int tlo = 0, thi = u.nsub >> 6;
    if (u.band) { const int a = u.q0 - u.band; tlo = a > 0 ? (a >> 6) : 0; const int b = ((u.q0 + RU - 1 + u.band) >> 6) + 1; thi = b < thi ? b : thi; }
    const float slope2 = u.sl_scale * exp2f(-u.sl_exp * (float)(u.hq0 + hl + 1));
    const int kr0 = tid / CPR, kc0 = tid - kr0 * CPR, c1 = tid + 512, kr1 = c1 / CPR, kc1 = c1 - kr1 * CPR;
    const bool k2 = (DQ == 96) && (tid < 256);
    const int vr_ = tid >> 3, vc_ = tid & 7;
    const bf16_t* kg0 = u.K + (size_t)kr0 * u.krs + kc0 * 8; const bf16_t* kg1 = u.K + (size_t)kr1 * u.krs + kc1 * 8; const bf16_t* vg = u.V + (size_t)vr_ * u.vrs + vc_ * 8;
    const int kl0 = kr0 * KP + kc0 * 16, kl1 = kr1 * KP + kc1 * 16, vl = V_OFF + vr_ * VP + vc_ * 16;
    f32x16 o0, o1, negm;
#pragma unroll
    for (int i = 0; i < 16; ++i) { o0[i] = 0.f; o1[i] = 0.f; negm[i] = -mb2; }
    float lsum = 0.f;
#define ATT_LOADK(t, S) do { const size_t ro_ = (size_t)(t) * 64; rk0##S = *(const u32x4*)(kg0 + ro_ * u.krs); if (k2) rk1##S = *(const u32x4*)(kg1 + ro_ * u.krs); } while (0)
#define ATT_LOADV(t, S) do { const size_t ro_ = (size_t)(t) * 64; rv##S = *(const u32x4*)(vg + ro_ * u.vrs); } while (0)
#define ATT_STOREK(b, S) do { *(ALAS u32x4*)(lds + (b) * KBUF + kl0) = rk0##S; if (k2) *(ALAS u32x4*)(lds + (b) * KBUF + kl1) = rk1##S; } while (0)
#define ATT_STOREV(b, S) do { *(ALAS u32x4*)(lds + (b) * VBUF + vl) = rv##S; } while (0)
#define ATT_SUMPACK4(X, B, PA) do { sacc = fadd_s(sacc, X[B]); sacc2 = fadd_s(sacc2, X[B + 1]); sacc = fadd_s(sacc, X[B + 2]); sacc2 = fadd_s(sacc2, X[B + 3]); sacc = fadd_s(sacc, X[B + 4]); sacc2 = fadd_s(sacc2, X[B + 5]); sacc = fadd_s(sacc, X[B + 6]); sacc2 = fadd_s(sacc2, X[B + 7]); \
        u32x4 w_; w_.x = cvtpk(X[B], X[B + 1]); w_.y = cvtpk(X[B + 2], X[B + 3]); w_.z = cvtpk(X[B + 4], X[B + 5]); w_.w = cvtpk(X[B + 6], X[B + 7]); PA = __builtin_bit_cast(bf16x8, w_); } while (0)
#define ATT_DENSE_BODY(t, P, Q) do { \
        if ((t) + 2 < NT) ATT_LOADK((t) + 2, P); if ((t) + 1 < NT) ATT_LOADV((t) + 1, Q); \
        if (wact) { \
            const ALAS unsigned char* kb = lds + (P) * KBUF + r * KP + h * 16; \
            const ALAS unsigned char* vb = lds + V_OFF + (Q) * VBUF + (4 * h + ((lane & 15) >> 2)) * VP + ((lane >> 4) & 1) * 32 + (lane & 3) * 8; \
            f32x16 S0 = negm, S1 = negm; bf16x8 pa[4]; float sacc = 0.f, sacc2 = 0.f; \
            _Pragma("unroll") for (int d0 = 0; d0 < NF; ++d0) { \
                const bf16x8 k0 = *(const ALAS bf16x8*)(kb + d0 * 32), k1 = *(const ALAS bf16x8*)(kb + 32 * KP + d0 * 32); \
                S0 = AMFMA(k0, qf[d0], S0); S1 = AMFMA(k1, qf[d0], S1); \
                if (d0 == 0) ATT_SUMPACK4(X0, 0, pa[0]); \
                if (d0 == 1) ATT_SUMPACK4(X0, 8, pa[1]); \
                if (d0 == 2) ATT_SUMPACK4(X1, 0, pa[2]); \
                if (d0 == 3) ATT_SUMPACK4(X1, 8, pa[3]); \
            } \
            lsum += sacc + sacc2; \
            _Pragma("unroll") for (int ks = 0; ks < 4; ++ks) { \
                const s16x4 lo0 = vtr(vb + ks * 16 * VP), hi0 = vtr(vb + (ks * 16 + 8) * VP), lo1 = vtr(vb + ks * 16 * VP + 64), hi1 = vtr(vb + (ks * 16 + 8) * VP + 64); \
                const bf16x8 vf0 = __builtin_shufflevector(lo0, hi0, 0, 1, 2, 3, 4, 5, 6, 7), vf1 = __builtin_shufflevector(lo1, hi1, 0, 1, 2, 3, 4, 5, 6, 7); \
                o0 = AMFMA(pa[ks], vf0, o0); o1 = AMFMA(pa[ks], vf1, o1); \
                _Pragma("unroll") for (int e = 0; e < 4; ++e) { X0[4 * ks + e] = __builtin_amdgcn_exp2f(S0[4 * ks + e]); X1[4 * ks + e] = __builtin_amdgcn_exp2f(S1[4 * ks + e]); } \
            } \
        } \
        if ((t) + 1 < NT) ATT_STOREK(Q, Q); ATT_STOREV(P, P); \
        __syncthreads(); } while (0)
    if (!u.band) {
        const int NT = u.nsub >> 6;
        u32x4 rk00, rk10 = (u32x4){0u, 0u, 0u, 0u}, rv0, rk01, rk11 = (u32x4){0u, 0u, 0u, 0u}, rv1;
        ATT_LOADK(0, 0); ATT_STOREK(0, 0);
        ATT_LOADK(1, 1); ATT_LOADV(0, 0);
        __syncthreads();
        f32x16 X0, X1;
#pragma unroll
        for (int i = 0; i < 16; ++i) { X0[i] = 0.f; X1[i] = 0.f; }
        {
            if (2 < NT) ATT_LOADK(2, 0); ATT_LOADV(1, 1);
            if (wact) {
                const ALAS unsigned char* kb = lds + r * KP + h * 16;
                f32x16 S0 = negm, S1 = negm;
#pragma unroll
                for (int d0 = 0; d0 < NF; ++d0) {
                    const bf16x8 k0 = *(const ALAS bf16x8*)(kb + d0 * 32), k1 = *(const ALAS bf16x8*)(kb + 32 * KP + d0 * 32);
                    S0 = AMFMA(k0, qf[d0], S0); S1 = AMFMA(k1, qf[d0], S1);
                }
#pragma unroll
                for (int i = 0; i < 16; ++i) { X0[i] = __builtin_amdgcn_exp2f(S0[i]); X1[i] = __builtin_amdgcn_exp2f(S1[i]); }
            }
            ATT_STOREK(1, 1); ATT_STOREV(0, 0);
            __syncthreads();
        }
        int t = 1;
        for (; t + 1 < NT; t += 2) { ATT_DENSE_BODY(t, 1, 0); ATT_DENSE_BODY(t + 1, 0, 1); }
        if (t < NT) ATT_DENSE_BODY(t, 1, 0);
        if (wact) {
            const ALAS unsigned char* vb = lds + V_OFF + ((NT - 1) & 1) * VBUF + (4 * h + ((lane & 15) >> 2)) * VP + ((lane >> 4) & 1) * 32 + (lane & 3) * 8;
            bf16x8 pa[4]; float sacc = 0.f, sacc2 = 0.f;
            ATT_SUMPACK4(X0, 0, pa[0]); ATT_SUMPACK4(X0, 8, pa[1]); ATT_SUMPACK4(X1, 0, pa[2]); ATT_SUMPACK4(X1, 8, pa[3]);
            lsum += sacc + sacc2;
#pragma unroll
            for (int ks = 0; ks < 4; ++ks) {
                const s16x4 lo0 = vtr(vb + ks * 16 * VP), hi0 = vtr(vb + (ks * 16 + 8) * VP), lo1 = vtr(vb + ks * 16 * VP + 64), hi1 = vtr(vb + (ks * 16 + 8) * VP + 64);
                const bf16x8 vf0 = __builtin_shufflevector(lo0, hi0, 0, 1, 2, 3, 4, 5, 6, 7), vf1 = __builtin_shufflevector(lo1, hi1, 0, 1, 2, 3, 4, 5, 6, 7);
                o0 = AMFMA(pa[ks], vf0, o0); o1 = AMFMA(pa[ks], vf1, o1);
            }
        }
        __syncthreads();
    } else if constexpr (DQ == 64) {
        constexpr int MAXT = 6, VB_OFF = MAXT * KBUF;
        const int nt = thi - tlo;
        u32x4 rk[MAXT], rv[MAXT];
#pragma unroll
        for (int i = 0; i < MAXT; ++i) if (i < nt) { const size_t ro_ = (size_t)(tlo + i) * 64; rk[i] = *(const u32x4*)(kg0 + ro_ * u.krs); rv[i] = *(const u32x4*)(vg + ro_ * u.vrs); }
#pragma unroll
        for (int i = 0; i < MAXT; ++i) if (i < nt) { *(ALAS u32x4*)(lds + i * KBUF + kl0) = rk[i]; *(ALAS u32x4*)(lds + VB_OFF + i * VBUF + (vl - V_OFF)) = rv[i]; }
        __syncthreads();
        for (int i = 0; i < nt; ++i) {
            const int t = tlo + i, tb = t * 64;
            if (!wact || tb + 63 < qs - u.band || tb > qs + 31 + u.band) continue;
            const ALAS unsigned char* kb = lds + i * KBUF + r * KP + h * 16;
            f32x16 p0 = negm, p1 = negm;
#pragma unroll
            for (int d0 = 0; d0 < NF; ++d0) {
                const bf16x8 k0 = *(const ALAS bf16x8*)(kb + d0 * 32), k1 = *(const ALAS bf16x8*)(kb + 32 * KP + d0 * 32);
                p0 = AMFMA(k0, qf[d0], p0); p1 = AMFMA(k1, qf[d0], p1);
            }
            const int rel_base = tb + 4 * h - (qs + r);
#pragma unroll
            for (int e = 0; e < 16; ++e) {
                const int rel0 = rel_base + (e & 3) + 8 * (e >> 2), rel1 = rel0 + 32;
                const int a0 = rel0 < 0 ? -rel0 : rel0, a1 = rel1 < 0 ? -rel1 : rel1;
                p0[e] = a0 <= u.band ? p0[e] - slope2 * (float)a0 : -INFINITY;
                p1[e] = a1 <= u.band ? p1[e] - slope2 * (float)a1 : -INFINITY;
            }
            float sacc = 0.f, sacc2 = 0.f;
#pragma unroll
            for (int e = 0; e < 16; ++e) { p0[e] = __builtin_amdgcn_exp2f(p0[e]); p1[e] = __builtin_amdgcn_exp2f(p1[e]); }
            bf16x8 pa[4];
            ATT_SUMPACK4(p0, 0, pa[0]); ATT_SUMPACK4(p0, 8, pa[1]); ATT_SUMPACK4(p1, 0, pa[2]); ATT_SUMPACK4(p1, 8, pa[3]);
            lsum += sacc + sacc2;
            const ALAS unsigned char* vb = lds + VB_OFF + i * VBUF + (4 * h + ((lane & 15) >> 2)) * VP + ((lane >> 4) & 1) * 32 + (lane & 3) * 8;
#pragma unroll
            for (int ks = 0; ks < 4; ++ks) {
                const s16x4 lo0 = vtr(vb + ks * 16 * VP), hi0 = vtr(vb + (ks * 16 + 8) * VP), lo1 = vtr(vb + ks * 16 * VP + 64), hi1 = vtr(vb + (ks * 16 + 8) * VP + 64);
                const bf16x8 vf0 = __builtin_shufflevector(lo0, hi0, 0, 1, 2, 3, 4, 5, 6, 7), vf1 = __builtin_shufflevector(lo1, hi1, 0, 1, 2, 3, 4, 5, 6, 7);
                o0 = AMFMA(pa[ks], vf0, o0); o1 = AMFMA(pa[ks], vf1, o1);
            }
        }
        __syncthreads();
    }
#undef ATT_LOADK
#undef ATT_LOADV
#undef ATT_STOREK
#undef ATT_STOREV
#undef ATT_SUMPACK4
#undef ATT_DENSE_BODY
    if (wact) {
        lsum += __shfl_xor(lsum, 32);
        if (u.sink) lsum += exp2f(u.sink[u.hq0 + hl] * LOG2E - mb2);
        const float linv = 1.f / lsum;
        bf16_t* op = u.O + (size_t)hl * u.ohs + r;
#pragma unroll
        for (int i = 0; i < 16; ++i) { const int qi = crow(i, h); const float f = __shfl(linv, qi); bf16_t* orow = op + (size_t)(qs + qi) * u.ors;
            orow[0] = (bf16_t)(cvtpk(o0[i] * f, 0.f) & 0xffffu); orow[32] = (bf16_t)(cvtpk(o1[i] * f, 0.f) & 0xffffu); }
        if (u.lse && h == 0) u.lse[(size_t)(qs + r) * u.lrs] = (mb2 + log2f(lsum)) * LN2;
    }
}

template <int DQ> __device__ __forceinline__ float logit_bound2(const float* gq, const float* gk, int lane) {
    float a = 0.f, b = 0.f;
    for (int i = lane; i < DQ; i += 64) { a = fmaxf(a, fabsf(gq[i])); b = fmaxf(b, fabsf(gk[i])); }
#pragma unroll
    for (int o = 1; o < 64; o <<= 1) { a = fmaxf(a, __shfl_xor(a, o)); b = fmaxf(b, __shfl_xor(b, o)); }
    return a * b * sqrtf((float)DQ) * LOG2E;
}
}

#define LAS __attribute__((address_space(3)))
typedef unsigned short bf16;
typedef unsigned v4u __attribute__((ext_vector_type(4)));
typedef float f32x4 __attribute__((ext_vector_type(4)));
constexpr int M = 32768, DM = 1024, FF = 2816, MP = 16384, SL = 2048;
constexpr size_t MiB = 1u << 20;
constexpr size_t WS_PS = 1 * MiB, WS_PS2 = 3 * MiB, WS_LSE = 5 * MiB, WS_W = 8 * MiB, WS_XB = 56 * MiB, WS_BIG = 120 * MiB, WS_END = 408 * MiB;
constexpr size_t W_UP0 = 0, W_DN0 = 11 * MiB, W_UP1 = 16 * MiB + MiB / 2, W_DN1 = 27 * MiB + MiB / 2, W_MIX = 33 * MiB;
constexpr int LDS_BYTES = 147456;
constexpr int NWAVES = 8;
constexpr float LOG2E = 1.4426950408889634f;

__device__ __forceinline__ unsigned f2bf(float f) { unsigned u = __builtin_bit_cast(unsigned, f); return (u + 0x7fffu + ((u >> 16) & 1u)) >> 16; }
__device__ __forceinline__ unsigned pk2(float lo, float hi) { return f2bf(lo) | (f2bf(hi) << 16); }
__device__ __forceinline__ float bflo(unsigned w) { return __uint_as_float(w << 16); }
__device__ __forceinline__ float bfhi(unsigned w) { return __uint_as_float(w & 0xffff0000u); }
__device__ __forceinline__ void ld8(const bf16* p, float (&v)[8]) { const v4u w = *(const v4u*)p; v[0] = bflo(w.x); v[1] = bfhi(w.x); v[2] = bflo(w.y); v[3] = bfhi(w.y); v[4] = bflo(w.z); v[5] = bfhi(w.z); v[6] = bflo(w.w); v[7] = bfhi(w.w); }
__device__ __forceinline__ void st8(bf16* p, const float (&v)[8]) { v4u w; w.x = pk2(v[0], v[1]); w.y = pk2(v[2], v[3]); w.z = pk2(v[4], v[5]); w.w = pk2(v[6], v[7]); *(v4u*)p = w; }
__device__ __forceinline__ float wave_sum(float v) {
#pragma unroll
    for (int o = 1; o < 64; o <<= 1) v += __shfl_xor(v, o);
    return v;
}

__device__ __forceinline__ void conv_item(const float* W, int K, int N, bf16* WT, int drow0, const float* g, LAS float* scr, int k0, int n0, int lane) {
#pragma unroll 8
    for (int i = 0; i < 32; ++i) { const int kk = 2 * i + (lane >> 5); float v = __builtin_nontemporal_load(W + (size_t)(k0 + kk) * N + n0 + (lane & 31)); if (g) v *= g[k0 + kk]; scr[kk * 33 + (lane & 31)] = v; }
    asm volatile("s_waitcnt lgkmcnt(0)" ::: "memory");
    const int c = lane & 7;
#pragma unroll
    for (int j = 0; j < 4; ++j) { const int n = (lane >> 3) + 8 * j; const LAS float* s = scr + (8 * c) * 33 + n;
        v4u o; o.x = pk2(s[0 * 33], s[1 * 33]); o.y = pk2(s[2 * 33], s[3 * 33]); o.z = pk2(s[4 * 33], s[5 * 33]); o.w = pk2(s[6 * 33], s[7 * 33]);
        *(v4u*)(WT + (size_t)(drow0 + n) * K + k0 + 8 * c) = o; }
    asm volatile("s_waitcnt lgkmcnt(0)" ::: "memory");
}
struct ConvD { const float* W; bf16* WT; const float* g; int K, N, dr, k0, n0; bool valid; };
__device__ __forceinline__ void conv_load(const ConvD& d, f32x4 (&v)[8], float (&gk)[8], int lane) {
    const int kr = lane >> 3, n4 = lane & 7;
#pragma unroll
    for (int i = 0; i < 8; ++i) { const int kk = 8 * i + kr; v[i] = __builtin_nontemporal_load((const f32x4*)(d.W + (size_t)(d.k0 + kk) * d.N + d.n0 + 4 * n4)); gk[i] = d.g ? d.g[d.k0 + kk] : 1.f; }
}
__device__ __forceinline__ void conv_finish(const ConvD& d, const f32x4 (&v)[8], const float (&gk)[8], LAS float* scr, int lane) {
    const int kr = lane >> 3, n4 = lane & 7;
#pragma unroll
    for (int i = 0; i < 8; ++i) { LAS float* p = scr + (8 * i + kr) * 33 + 4 * n4; p[0] = v[i][0] * gk[i]; p[1] = v[i][1] * gk[i]; p[2] = v[i][2] * gk[i]; p[3] = v[i][3] * gk[i]; }
    asm volatile("s_waitcnt lgkmcnt(0)" ::: "memory");
    const int c = lane & 7;
#pragma unroll
    for (int j = 0; j < 4; ++j) { const int n = (lane >> 3) + 8 * j; const LAS float* sp = scr + (8 * c) * 33 + n;
        v4u o; o.x = pk2(sp[0 * 33], sp[1 * 33]); o.y = pk2(sp[2 * 33], sp[3 * 33]); o.z = pk2(sp[4 * 33], sp[5 * 33]); o.w = pk2(sp[6 * 33], sp[7 * 33]);
        *(v4u*)(d.WT + (size_t)(d.dr + n) * d.K + d.k0 + 8 * c) = o; }
    asm volatile("s_waitcnt lgkmcnt(0)" ::: "memory");
}
#define CJD(Wp, K_, N_, WTp, gp, MODE, ROWOFF) if (!d.valid) { const int nblk_ = (N_) / 32, nit_ = ((K_) / 64) * nblk_; if (r < nit_) { const int kb_ = r / nblk_, nb_ = r - kb_ * nblk_, n0_ = 32 * nb_; \
    d.W = (Wp); d.K = (K_); d.N = (N_); d.WT = (WTp); d.g = (gp); d.k0 = 64 * kb_; d.n0 = n0_; d.valid = true; \
    d.dr = (MODE) == 1 ? 256 * (n0_ >> 7) + (n0_ & 127) + (ROWOFF) : ((MODE) == 2 ? 256 * (n0_ >> 8) + 128 * ((n0_ >> 5) & 1) + 32 * ((n0_ >> 6) & 3) + (ROWOFF) : n0_ + (ROWOFF)); } else r -= nit_; }
#define CJ(Wp, K_, N_, WTp, gp, MODE, ROWOFF) { const int nblk_ = (N_) / 32, nit_ = ((K_) / 64) * nblk_; if (r < nit_) { const int kb_ = r / nblk_, nb_ = r - kb_ * nblk_, n0_ = 32 * nb_; \
    const int dr_ = (MODE) == 1 ? 256 * (n0_ >> 7) + (n0_ & 127) + (ROWOFF) : ((MODE) == 2 ? 256 * (n0_ >> 8) + 128 * ((n0_ >> 5) & 1) + 32 * ((n0_ >> 6) & 3) + (ROWOFF) : n0_ + (ROWOFF)); conv_item((Wp), (K_), (N_), (WTp), dr_, (gp), scr, 64 * kb_, n0_, lane); continue; } r -= nit_; }

#define RLX_AGENT __ATOMIC_RELAXED, __HIP_MEMORY_SCOPE_AGENT
#define XB_TMO      128
#define XB_XCNT(j)  (256  + 64 * (j))
#define XB_XSUB(j)  (1280 + 64 * (j))
#define XB_XGEN(j)  (2304 + 64 * (j))
#define XB_TOP      3328
#define XB_TOPGEN   3392
#define XCD_BAR_WORDS 3456
#define XB_SPIN_CAP (1u << 18)

__device__ __forceinline__ unsigned xb_ld(unsigned* p)              { return __hip_atomic_load(p, __ATOMIC_RELAXED, __HIP_MEMORY_SCOPE_AGENT); }
__device__ __forceinline__ unsigned xb_add(unsigned* p, unsigned v) { return __hip_atomic_fetch_add(p, v, __ATOMIC_RELAXED, __HIP_MEMORY_SCOPE_AGENT); }
__device__ __forceinline__ unsigned xb_xcc_id() { return (unsigned)__builtin_amdgcn_s_getreg((3 << 11) | 20) & 0xFu; }
#define XB_SPIN(cond, bar) do { unsigned _sp = 0; while (cond) { __builtin_amdgcn_s_sleep(1); \
    if ((++_sp & 255u) == 0u) { if (xb_ld(&(bar)[XB_TMO])) break; if (_sp > XB_SPIN_CAP) { atomicAdd(&(bar)[XB_TMO], 1u); break; } } } } while (0)

struct XcdBarrier {
    unsigned* bar; unsigned x;
    volatile LAS unsigned* st;
};

__device__ __forceinline__ XcdBarrier xcd_barrier_post(unsigned* bar, volatile LAS unsigned* st) {
    XcdBarrier b; b.bar = bar; b.x = xb_xcc_id(); b.st = st;
    if (threadIdx.x == 0) (void)xb_add(&bar[XB_XCNT(b.x)], 1u);
    return b;
}
__device__ __forceinline__ void xcd_barrier_complete(unsigned* bar, unsigned x, unsigned& nloc, unsigned& nx) {
    const unsigned G = gridDim.x * gridDim.y * gridDim.z;
    unsigned sum, cnt, mine, sp = 0u;
    for (;;) {
        sum = 0u; cnt = 0u; mine = 0u;
#pragma unroll
        for (unsigned j = 0; j < 16; ++j) { const unsigned c = xb_ld(&bar[XB_XCNT(j)]); sum += c; cnt += (c > 0u) ? 1u : 0u; mine = (j == x) ? c : mine; }
        if (sum == G) break;
        __builtin_amdgcn_s_sleep(1);
        if ((++sp & 255u) == 0u) { if (xb_ld(&bar[XB_TMO])) break; if (sp > XB_SPIN_CAP) { atomicAdd(&bar[XB_TMO], 1u); break; } }
    }
    nloc = mine > 0u ? mine : 1u; nx = cnt > 0u ? cnt : 1u;
}

__device__ __forceinline__ void xcd_barrier(const XcdBarrier& b) {
    asm volatile("s_waitcnt vmcnt(0)" ::: "memory");
    __syncthreads();
    if (threadIdx.x == 0) {
        unsigned* bar = b.bar;
        __builtin_amdgcn_s_waitcnt(0);
        unsigned nloc = b.st[0], nx = b.st[1];
        if (nloc == 0u) { xcd_barrier_complete(bar, b.x, nloc, nx); b.st[0] = nloc; b.st[1] = nx; }
        const unsigned old = xb_add(&bar[XB_XSUB(b.x)], 1u);
        const unsigned gen = old / nloc;
        if (old + 1u == (gen + 1u) * nloc) {
            __builtin_amdgcn_fence(__ATOMIC_RELEASE, "agent");
            asm volatile("s_waitcnt vmcnt(0)" ::: "memory");
            const unsigned og = xb_add(&bar[XB_TOP], 1u);
            const unsigned tg = og / nx;
            if (og + 1u == (tg + 1u) * nx) xb_add(&bar[XB_TOPGEN], 1u);
            else XB_SPIN(xb_ld(&bar[XB_TOPGEN]) == tg, bar);
            __builtin_amdgcn_fence(__ATOMIC_ACQUIRE, "agent");
            xb_add(&bar[XB_XGEN(b.x)], 1u);
            asm volatile("s_waitcnt vmcnt(0)" ::: "memory");
        } else {
            XB_SPIN(xb_ld(&bar[XB_XGEN(b.x)]) == gen, bar);
            __builtin_amdgcn_fence(__ATOMIC_ACQUIRE, "agent");
            asm volatile("s_waitcnt vmcnt(0)" ::: "memory");
        }
    }
    __syncthreads();
}

struct Args { const float* in[33]; float* out; unsigned char* ws; };

__device__ __forceinline__ void conv_phase(const Args& a, int L, LAS unsigned char* lds, int gw, int NGW, int lane, int wave) {
    LAS float* scr = (LAS float*)(lds + wave * 16384);
    bf16* Wb = (bf16*)(a.ws + WS_W);
    const size_t so = (size_t)L * DM * FF;
    const float* g1 = a.in[2] + L * DM; const float* gm = a.in[6] + L * DM; const float* g2 = a.in[7] + L * DM;
    bf16* up0 = Wb + W_UP0 / 2; bf16* dn0 = Wb + W_DN0 / 2; bf16* up1 = Wb + W_UP1 / 2; bf16* dn1 = Wb + W_DN1 / 2; bf16* mix = Wb + W_MIX / 2;
#define CONV_DECODE(dd, item) do { ConvD d; d.valid = false; d.W = nullptr; d.WT = nullptr; d.g = nullptr; d.K = 0; d.N = 0; d.dr = 0; d.k0 = 0; d.n0 = 0; int r = (item); \
        if (r < 16384) { \
        CJD(a.in[3] + so, DM, FF, up0, g1, 1, 0) \
        CJD(a.in[4] + so, DM, FF, up0, g1, 1, 128) \
        CJD(a.in[5] + so, FF, DM, dn0, (const float*)nullptr, 0, 0) \
        CJD(a.in[8] + so, DM, FF, up1, g2, 1, 0) \
        CJD(a.in[9] + so, DM, FF, up1, g2, 1, 128) \
        CJD(a.in[10] + so, FF, DM, dn1, (const float*)nullptr, 0, 0) \
        if (L == 0) { \
            CJD(a.in[11], DM, 1536, mix, gm, 2, 0) \
            CJD(a.in[15], DM, DM, mix + 3 * MiB / 2, (const float*)nullptr, 0, 0) \
        } else if (L == 1) { \
            CJD(a.in[16], DM, 512, mix, gm, 0, 0) \
            CJD(a.in[19], DM, 288, mix, gm, 0, 512) \
            CJD(a.in[18], 512, 1536, mix + 2 * MiB / 2, a.in[17], 0, 0) \
            CJD(a.in[21], 256, 2048, mix + (3 * MiB + MiB / 2) / 2, a.in[20], 0, 0) \
            CJD(a.in[24], DM, DM, mix + (4 * MiB + MiB / 2) / 2, (const float*)nullptr, 0, 0) \
        } else if (L == 2) { \
            CJD(a.in[25], DM, 4608, mix, gm, 2, 0) \
            CJD(a.in[28], 512, DM, mix + 9 * MiB / 2, (const float*)nullptr, 0, 0) \
        } else { \
            CJD(a.in[29], DM, 1536, mix, gm, 0, 0) \
            CJD(a.in[32], DM, DM, mix + 3 * MiB / 2, (const float*)nullptr, 0, 0) \
        } } \
        dd = d; } while (0)
    {
        f32x4 va[8], vb[8]; float ga[8], gb[8]; ConvD d0, d1;
        int it = gw;
        CONV_DECODE(d0, it);
        if (d0.valid) {
            conv_load(d0, va, ga, lane);
            for (;;) {
                CONV_DECODE(d1, it + NGW); if (d1.valid) conv_load(d1, vb, gb, lane);
                conv_finish(d0, va, ga, scr, lane);
                if (!d1.valid) break;
                it += 2 * NGW;
                CONV_DECODE(d0, it); if (d0.valid) conv_load(d0, va, ga, lane);
                conv_finish(d1, vb, gb, scr, lane);
                if (!d0.valid) break;
            }
        }
    }
#undef CONV_DECODE
    if (L == 1) {
        v4u* z = (v4u*)(mix + (size_t)800 * 1024);
        for (int i = gw * 64 + lane; i < 224 * 1024 / 8; i += NGW * 64) z[i] = (v4u){0u, 0u, 0u, 0u};
    }
    if (L == 0) {
        bf16* XB = (bf16*)(a.ws + WS_XB); float* PS = (float*)(a.ws + WS_PS);
        for (int row = gw; row < M; row += NGW) {
            const float* src = row < MP ? a.in[0] + (size_t)row * DM : a.in[1] + (size_t)(row - MP) * DM;
            const f32x4* xr = (const f32x4*)src + lane; unsigned long long* xb = (unsigned long long*)(XB + (size_t)row * DM) + lane;
            float ss = 0.f;
#pragma unroll
            for (int j = 0; j < 4; ++j) { const f32x4 v = __builtin_nontemporal_load(xr + 64 * j); ss += (v[0] * v[0] + v[1] * v[1]) + (v[2] * v[2] + v[3] * v[3]);
                xb[64 * j] = (unsigned long long)pk2(v[0], v[1]) | ((unsigned long long)pk2(v[2], v[3]) << 32); }
            ss = wave_sum(ss);
            if (lane < 16) PS[(size_t)row * 16 + lane] = lane == 0 ? ss : 0.f;
        }
    }
}

__device__ __forceinline__ int seq_pos(int row) { return row < MP ? row : ((row - MP) & (SL - 1)); }

__device__ __forceinline__ void prep64(bf16* buf, int kind, const float* gq, const float* gk, int gw, int NGW, int lane) {
    const int pitch = kind == 2 ? 4608 : 1536, nvec = kind == 2 ? 48 : 20, c = lane & 7, grp = lane >> 3;
    float gqv[8], gkv[8], inv[8];
#pragma unroll
    for (int e = 0; e < 8; ++e) { gqv[e] = gq[8 * c + e] * (0.125f * LOG2E); gkv[e] = gk[8 * c + e]; inv[e] = powf(10000.f, -(float)(8 * (c & 1) + e) * (1.f / 16.f)); }
    for (int tb = gw; tb < M / 8; tb += NGW) {
        const int row = tb * 8 + grp;
        bf16* rp = buf + (size_t)row * pitch + 8 * c;
        float cs[8], sn[8];
        if (kind == 3) { const int t = seq_pos(row); const float pos = (float)((c & 4) ? (t & 63) : (t >> 6));
#pragma unroll
            for (int e = 0; e < 8; ++e) { const float ang = pos * inv[e]; cs[e] = cosf(ang); sn[e] = sinf(ang); } }
        for (int v0 = 0; v0 < nvec; v0 += 4) {
            float v[4][8];
#pragma unroll
            for (int j = 0; j < 4; ++j) { const int vi = v0 + j; ld8(rp + (kind == 2 ? 1536 * (vi >> 4) + 64 * (vi & 15) : 64 * vi), v[j]); }
#pragma unroll
            for (int j = 0; j < 4; ++j) {
                const int vi = v0 + j; const bool isq = kind == 2 ? ((vi & 15) < 8) : (vi < 16);
                float ss = 0.f;
#pragma unroll
                for (int e = 0; e < 8; ++e) ss += v[j][e] * v[j][e];
                ss += __shfl_xor(ss, 1); ss += __shfl_xor(ss, 2); ss += __shfl_xor(ss, 4);
                const float rs = rsqrtf(ss * (1.f / 64.f) + 1e-6f);
#pragma unroll
                for (int e = 0; e < 8; ++e) v[j][e] = v[j][e] * rs;
                if (kind == 3) {
#pragma unroll
                    for (int e = 0; e < 8; ++e) { const float mine = v[j][e] * (isq ? gqv[e] : gkv[e]); const float other = __shfl_xor(mine, 2); v[j][e] = (c & 2) ? other * sn[e] + mine * cs[e] : mine * cs[e] - other * sn[e]; }
                } else {
#pragma unroll
                    for (int e = 0; e < 8; ++e) v[j][e] *= (isq ? gqv[e] : gkv[e]);
                }
            }
#pragma unroll
            for (int j = 0; j < 4; ++j) { const int vi = v0 + j; st8(rp + (kind == 2 ? 1536 * (vi >> 4) + 64 * (vi & 15) : 64 * vi), v[j]); }
        }
    }
}

__device__ __forceinline__ void prep_mla(bf16* Qraw, bf16* Kb, const bf16* CQ, const float* gq, const float* gk, int gw, int NGW, int lane) {
    const int c = lane & 15, grp = lane >> 4; const bool live = c < 12, rot = c >= 8 && c < 12;
    float gqv[8], gkv[8], inv[8];
#pragma unroll
    for (int e = 0; e < 8; ++e) { gqv[e] = live ? gq[8 * c + e] * (0.10206207261596575f * LOG2E) : 0.f; gkv[e] = live ? gk[8 * c + e] : 0.f; inv[e] = powf(10000.f, -(float)(8 * (c & 1) + e) * (1.f / 16.f)); }
    for (int tb = gw; tb < M / 4; tb += NGW) {
        const int row = tb * 4 + grp;
        const float pos = (float)seq_pos(row);
        float cs[8], sn[8];
#pragma unroll
        for (int e = 0; e < 8; ++e) { const float ang = pos * inv[e]; cs[e] = cosf(ang); sn[e] = sinf(ang); }
        float kr[8];
#pragma unroll
        for (int e = 0; e < 8; ++e) kr[e] = 0.f;
        if (rot) ld8(CQ + (size_t)row * 1024 + 768 + 8 * (c - 8), kr);
        bf16* qrow = Qraw + (size_t)row * 1536 + 8 * c; bf16* krow = Kb + (size_t)row * 1536 + 8 * c;
        for (int h0 = 0; h0 < 16; h0 += 2) {
            float v[4][8];
#pragma unroll
            for (int j = 0; j < 4; ++j) {
                const int hh = h0 + (j >> 1); const bool isk = j & 1;
#pragma unroll
                for (int e = 0; e < 8; ++e) v[j][e] = 0.f;
                if (isk) { if (c < 8) ld8(krow + hh * 96, v[j]); else {
#pragma unroll
                        for (int e = 0; e < 8; ++e) v[j][e] = kr[e]; } }
                else if (live) ld8(qrow + hh * 96, v[j]);
            }
#pragma unroll
            for (int j = 0; j < 4; ++j) {
                const bool isk = j & 1;
                float ss = 0.f;
#pragma unroll
                for (int e = 0; e < 8; ++e) ss += v[j][e] * v[j][e];
                ss += __shfl_xor(ss, 1); ss += __shfl_xor(ss, 2); ss += __shfl_xor(ss, 4); ss += __shfl_xor(ss, 8);
                const float rs = rsqrtf(ss * (1.f / 96.f) + 1e-6f);
#pragma unroll
                for (int e = 0; e < 8; ++e) { const float mine = v[j][e] * rs * (isk ? gkv[e] : gqv[e]); const float other = __shfl_xor(mine, 2);
                    v[j][e] = rot ? ((c & 2) ? other * sn[e] + mine * cs[e] : mine * cs[e] - other * sn[e]) : mine; }
            }
#pragma unroll
            for (int j = 0; j < 4; ++j) { const int hh = h0 + (j >> 1); if (live) st8(((j & 1) ? krow : qrow) + hh * 96, v[j]); }
        }
    }
}

__device__ __forceinline__ void merge_c(bf16* buf, const float* LSE, int gw, int NGW, int lane) {
    const int hh = lane >> 3, c = lane & 7;
    for (int row = gw; row < M; row += NGW) {
        const float l0 = LSE[((size_t)0 * M + row) * 8 + hh], l1 = LSE[((size_t)1 * M + row) * 8 + hh], l2 = LSE[((size_t)2 * M + row) * 8 + hh];
        const float mx = fmaxf(l0, fmaxf(l1, l2)); const float e0 = __expf(l0 - mx), e1 = __expf(l1 - mx), e2 = __expf(l2 - mx); const float inv = 1.f / (e0 + e1 + e2);
        bf16* rp = buf + (size_t)row * 4608 + hh * 64 + 8 * c;
        float a[8], b[8], d[8], o[8]; ld8(rp, a); ld8(rp + 1536, b); ld8(rp + 3072, d);
#pragma unroll
        for (int e = 0; e < 8; ++e) o[e] = (a[e] * e0 + b[e] * e1 + d[e] * e2) * inv;
        st8(rp + 512, o);
    }
}

struct DecAD {
    bf16* buf; const float* sink; int band; bf16* obase; int opitch; int r2;
    __device__ __forceinline__ att::AU operator()(int list, int ui) const {
        int kvh, blk, base, nsub;
        if (list == 0) { kvh = ui >> 8; blk = ui & 255; base = 0; nsub = MP; } else { const int b = ui >> 7; kvh = (ui >> 5) & 3; blk = ui & 31; base = MP + b * SL; nsub = SL; }
        att::AU u; bf16* q = buf + (size_t)base * 1536 + kvh * 256;
        u.Q = q; u.O = obase ? obase + (size_t)base * opitch + kvh * 256 : q; u.K = buf + (size_t)base * 1536 + 1024 + kvh * 64; u.V = buf + (size_t)base * 1536 + 1280 + kvh * 64; u.lse = nullptr; u.sink = sink;
        u.qrs = u.krs = u.vrs = 1536; u.ors = obase ? opitch : 1536; u.lrs = 0; u.q0 = blk * 64; u.nsub = nsub; u.wph = 2; u.qhs = u.ohs = 64; u.band = band; u.hq0 = kvh * 4; u.sl_scale = att::LOG2E; u.sl_exp = 0.5f; u.r2 = r2;
        if (r2) { if (list == 0) { kvh = ui >> 7; blk = ui & 127; } else { const int b = ui >> 6; kvh = (ui >> 4) & 3; blk = ui & 15; base = MP + b * SL; }
            bf16* q2 = buf + (size_t)base * 1536 + kvh * 256; u.Q = q2; u.O = obase ? obase + (size_t)base * opitch + kvh * 256 : q2; u.K = buf + (size_t)base * 1536 + 1024 + kvh * 64; u.V = buf + (size_t)base * 1536 + 1280 + kvh * 64; u.q0 = blk * 128; u.hq0 = kvh * 4; }
        return u;
    }
};
struct DecB {
    const bf16* Q; const bf16* K; const bf16* V; bf16* O;
    __device__ __forceinline__ att::AU operator()(int list, int ui) const {
        int hh, blk, base, nsub;
        if (list == 0) { hh = ui >> 6; blk = ui & 63; base = 0; nsub = MP; } else { const int b = ui >> 7; hh = (ui >> 3) & 15; blk = ui & 7; base = MP + b * SL; nsub = SL; }
        att::AU u; u.Q = Q + (size_t)base * 1536 + hh * 96; u.K = K + (size_t)base * 1536 + hh * 96; u.V = V + (size_t)base * 1024 + hh * 64; u.O = O + (size_t)base * 1024 + hh * 64; u.lse = nullptr; u.sink = nullptr;
        u.qrs = u.krs = 1536; u.vrs = u.ors = 1024; u.lrs = 0; u.q0 = blk * 256; u.nsub = nsub; u.wph = 8; u.qhs = u.ohs = 0; u.band = 0; u.hq0 = hh; u.sl_scale = 0.f; u.sl_exp = 0.f; u.r2 = 1;
        { int hh2, blk2, base2; if (list == 0) { hh2 = ui >> 5; blk2 = ui & 31; base2 = 0; } else { const int b2 = ui >> 6; hh2 = (ui >> 2) & 15; blk2 = ui & 3; base2 = MP + b2 * SL; }
          u.Q = Q + (size_t)base2 * 1536 + hh2 * 96; u.K = K + (size_t)base2 * 1536 + hh2 * 96; u.V = V + (size_t)base2 * 1024 + hh2 * 64; u.O = O + (size_t)base2 * 1024 + hh2 * 64; u.q0 = blk2 * 512; u.hq0 = hh2; }
        return u;
    }
};
struct DecC {
    bf16* buf; float* LSE;
    __device__ __forceinline__ att::AU operator()(int list, int ui) const {
        int g, hh, blk, rr, base, len;
        if (list == 0) { g = ui >> 9; const int w = ui & 511, nbs = 6 - 2 * g; blk = w & ((1 << nbs) - 1); hh = (w >> nbs) & 7; rr = w >> (nbs + 3); base = 0; len = MP; }
        else { const int sq = ui >> 8; int w = ui & 255; base = MP + sq * SL; len = SL;
            if (w < 64) { g = 0; hh = w >> 3; blk = w & 7; rr = 0; } else if (w < 128) { w -= 64; g = 1; blk = w & 1; hh = (w >> 1) & 7; rr = w >> 4; } else { w -= 128; g = 2; blk = 0; hh = w & 7; rr = w >> 3; } }
        const int dil = 1 << (2 * g), t0 = base + rr;
        att::AU u; bf16* q = buf + (size_t)t0 * 4608 + g * 1536 + hh * 64;
        u.Q = q; u.O = q; u.K = q + 512; u.V = q + 1024; u.lse = LSE + ((size_t)g * M + t0) * 8 + hh; u.sink = nullptr;
        u.qrs = u.krs = u.vrs = u.ors = (long)dil * 4608; u.lrs = 8 * dil; u.q0 = blk * 256; u.nsub = len >> (2 * g); u.wph = 8; u.qhs = u.ohs = 0; u.band = 64; u.hq0 = hh; u.sl_scale = att::LOG2E * (float)dil; u.sl_exp = 1.0f; u.r2 = 0;
        return u;
    }
};
template <int DQ, class Dec> __device__ __forceinline__ void attn_phase(LAS unsigned char* lds, int G, int vcu, int n0, int n1, const Dec& dec, float mb2) {
    for (int list = 0; list < 2; ++list) {
        const int n = list ? n1 : n0, per = (n + G - 1) / G;
        for (int i = 0; i < per; ++i) { const int ui = vcu * per + i; if (ui < n) { const att::AU u = dec(list, ui); att::attn_unit<DQ>(u, lds, mb2); } }
    }
}

enum Kind { K_NOP = 0, K_CONV, K_SWIGLU, K_RES, K_BF16, K_PREP, K_ATTN, K_MERGE };

__global__ void __launch_bounds__(NWAVES * 64, 2) fwd_megakernel(Args a) {
    extern __shared__ __attribute__((aligned(16))) unsigned char lds_raw[];
    LAS unsigned char* lds = (LAS unsigned char*)lds_raw;
    cg::grid_group grid = cg::this_grid();
    for (int u_ = threadIdx.x; u_ < (LDS_BYTES - 131072) / 4; u_ += NWAVES * 64) ((LAS unsigned*)(lds + 131072))[u_] = 0u;
    __syncthreads();
    const XcdBarrier xbar = xcd_barrier_post((unsigned*)a.ws, (volatile LAS unsigned*)(lds + 131072 + 320) + 8);
    const int G = gridDim.x, bx = blockIdx.x, vcu = (G % 8 == 0) ? (bx % 8) * (G / 8) + bx / 8 : bx;
    const int NGW = G * NWAVES;
    unsigned char* ws = a.ws;
    float* PS = (float*)(ws + WS_PS); float* PS2 = (float*)(ws + WS_PS2); float* LSE = (float*)(ws + WS_LSE);
    bf16* Wb = (bf16*)(ws + WS_W); bf16* XB = (bf16*)(ws + WS_XB); bf16* BIG = (bf16*)(ws + WS_BIG);
    bf16* mix = Wb + W_MIX / 2;
    bf16* QRAW = BIG + 32 * MiB;
    bf16* KB = BIG + 80 * MiB;

#ifdef PROBE_UP2
    constexpr int SPL = 14, S_UP0 = 1, S_UP0B = 2, S_DN0 = 3, S_MIX0 = 4, S_UP1 = 11, S_UP1B = 12, S_DN1 = 13;
#else
    constexpr int SPL = 12, S_UP0 = 1, S_UP0B = -1, S_DN0 = 2, S_MIX0 = 3, S_UP1 = 10, S_UP1B = -1, S_DN1 = 11;
#endif
    for (int step = 0; step < 4 * SPL; ++step) {
        int tid_o = threadIdx.x; asm volatile("" : "+v"(tid_o));
        const int lane = tid_o & 63, wave = __builtin_amdgcn_readfirstlane(tid_o >> 6), gw = vcu * NWAVES + wave;
        const int L = step / SPL, s = step - L * SPL;
        int kind = K_NOP; bool nosync = false;
        pg8::Gemm g; g.A = nullptr; g.Bt = nullptr; g.M = M; g.N = 0; g.K = 0; g.lda = 0;
        float alpha = 1.f;
        pg8::EpiBf16 eb; eb.O = BIG; eb.O2 = XB; eb.ldc = 0; eb.ps_in = PS; eb.off4 = 0; eb.n4 = 4; eb.inv_dim = 1.f / 1024.f; eb.ps_out = PS2; eb.mode = 0; eb.gq = nullptr; eb.gk = nullptr; eb.nq = 0; eb.nke = 0;
        if (s == 0) kind = K_CONV;
        else if (s == S_UP0 || s == S_UP0B || s == S_UP1 || s == S_UP1B) { kind = K_SWIGLU; g.A = XB; g.lda = DM; g.Bt = Wb + (s < S_MIX0 ? W_UP0 : W_UP1) / 2; g.N = 2 * FF; g.K = DM; }
        else if (s == S_DN0 || s == S_DN1) { kind = K_RES; g.A = BIG; g.lda = FF; g.Bt = Wb + (s == S_DN0 ? W_DN0 : W_DN1) / 2; g.N = DM; g.K = FF; alpha = 0.5f; }
        else {
            int k = s - S_MIX0;
#ifdef PROBE_ATTN2
            if (L == 1 && k >= 5) k -= 1;
            if (L == 3 && k >= 3) k -= 1;
#else
            if (k == 6) k = 7;
#endif
            if (L == 0 || L == 3) {
                if (k == 0) { kind = K_BF16; g.A = XB; g.lda = DM; g.Bt = mix; g.N = 1536; g.K = DM; eb.ldc = 1536; if (L == 0) { eb.mode = 3; eb.gq = a.in[12]; eb.gk = a.in[13]; eb.nq = 4; eb.nke = 5; } }
                else if (k == 1) { if (L == 3) kind = K_PREP; }
                else if (k == 2) kind = K_ATTN;
                else if (k == 3) { kind = K_RES; g.A = L == 0 ? BIG : BIG + 48 * MiB; g.lda = L == 0 ? 1536 : 1024; g.Bt = mix + 3 * MiB / 2; g.N = DM; g.K = DM; }
            } else if (L == 1) {
                if (k == 0) { kind = K_BF16; g.A = XB; g.lda = DM; g.Bt = mix; g.N = 1024; g.K = DM; eb.ldc = 1024; eb.mode = 1; }
                else if (k == 1) { kind = K_BF16; nosync = true; g.A = BIG; g.lda = 1024; g.Bt = mix + 2 * MiB / 2; g.N = 1536; g.K = 512; eb.O = QRAW; eb.ldc = 1536; eb.ps_in = PS2; eb.off4 = 0; eb.n4 = 2; eb.inv_dim = 1.f / 512.f; }
                else if (k == 2) { kind = K_BF16; g.A = BIG + 512; g.lda = 1024; g.Bt = mix + (3 * MiB + MiB / 2) / 2; g.N = 2048; g.K = 256; eb.O = KB; eb.O2 = (bf16*)a.out; eb.ldc = 1536; eb.ps_in = PS2; eb.off4 = 2; eb.n4 = 1; eb.inv_dim = 1.f / 256.f; eb.mode = 2; }
                else if (k == 3) kind = K_PREP;
                else if (k == 4) kind = K_ATTN;
                else if (k == 5) { kind = K_RES; g.A = BIG; g.lda = 1024; g.Bt = mix + (4 * MiB + MiB / 2) / 2; g.N = DM; g.K = DM; }
            } else {
                if (k == 0) { kind = K_BF16; g.A = XB; g.lda = DM; g.Bt = mix; g.N = 4608; g.K = DM; eb.ldc = 4608; eb.mode = 3; eb.gq = a.in[26]; eb.gk = a.in[27]; eb.nq = 2; eb.nke = 4; }
                else if (k == 1) { }
                else if (k == 2) kind = K_ATTN;
                else if (k == 3) kind = K_MERGE;
                else if (k == 4) { kind = K_RES; g.A = BIG + 512; g.lda = 4608; g.Bt = mix + 9 * MiB / 2; g.N = DM; g.K = 512; }
            }
        }
        if (kind == K_NOP) continue;
        if (kind == K_CONV) conv_phase(a, L, lds, gw, NGW, lane, wave);
        else if (kind == K_SWIGLU) { pg8::StaticOrder S; S.init(M, g.N, G, bx); pg8::EpiSwiglu E{BIG, PS}; pg8::gemm_phase<pg8::EpiSwiglu, pg8::StaticOrder, true, true>(lds, g, S, E); }
        else if (kind == K_RES) { pg8::StaticOrder S; S.init(M, g.N, G, bx); pg8::EpiRes E{step == 4 * SPL - 1 ? a.out : (float*)nullptr, XB, PS, alpha}; pg8::gemm_phase<pg8::EpiRes, pg8::StaticOrder, true, true>(lds, g, S, E); }
        else if (kind == K_BF16) { pg8::StaticOrder S; S.init(M, g.N, G, bx); pg8::gemm_phase<pg8::EpiBf16, pg8::StaticOrder, true, true>(lds, g, S, eb); }
        else if (kind == K_PREP) {
            if (L == 0) prep64(BIG, 0, a.in[12], a.in[13], gw, NGW, lane);
            else if (L == 1) prep_mla(QRAW, KB, BIG, a.in[22], a.in[23], gw, NGW, lane);
            else if (L == 2) prep64(BIG, 2, a.in[26], a.in[27], gw, NGW, lane);
            else prep64(BIG, 3, a.in[30], a.in[31], gw, NGW, lane);
        }
        else if (kind == K_ATTN) {
            if (L == 1) { const float mb2 = att::logit_bound2<96>(a.in[22], a.in[23], lane); DecB d{QRAW, KB, (const bf16*)a.out, BIG}; attn_phase<96, DecB>(lds, G, vcu, 512, 512, d, mb2); }
            else if (L == 2) { const float mb2 = att::logit_bound2<64>(a.in[26], a.in[27], lane); DecC d{BIG, LSE}; attn_phase<64, DecC>(lds, G, vcu, 1536, 2048, d, mb2); }
            else { const float mb2 = att::logit_bound2<64>(L == 0 ? a.in[12] : a.in[30], L == 0 ? a.in[13] : a.in[31], lane);
                   DecAD d{BIG, L == 0 ? a.in[14] : (const float*)nullptr, L == 0 ? 128 : 0, L == 0 ? (bf16*)nullptr : BIG + 48 * MiB, 1024, L == 0 ? 0 : 1}; attn_phase<64, DecAD>(lds, G, vcu, L == 0 ? 1024 : 512, L == 0 ? 1024 : 512, d, mb2); }
        }
        else if (kind == K_MERGE) merge_c(BIG, LSE, gw, NGW, lane);
        if (nosync || step == 4 * SPL - 1) continue;
        if (step == 0) grid.sync();
        else xcd_barrier(xbar);
    }
}

extern "C" void kernel_launch(void* const* d_in, const int* in_sizes, int n_in, void* d_out, int out_size, void* d_ws, size_t ws_size, hipStream_t stream) {
    static int grid = 0;
    if (grid == 0) {
        if (n_in != 33 || out_size != M * DM || ws_size < WS_END) { fprintf(stderr, "kernel_launch: unexpected shapes (n_in %d, out %d, ws %zu)\n", n_in, out_size, ws_size); grid = -1; return; }
        int dev = 0, cus = 0, per_cu = 0;
        hipGetDevice(&dev); hipDeviceGetAttribute(&cus, hipDeviceAttributeMultiprocessorCount, dev);
        hipFuncSetAttribute((const void*)fwd_megakernel, hipFuncAttributeMaxDynamicSharedMemorySize, LDS_BYTES);
        hipOccupancyMaxActiveBlocksPerMultiprocessor(&per_cu, (const void*)fwd_megakernel, NWAVES * 64, LDS_BYTES);
        if (per_cu < 1) per_cu = 1;
        (void)hipGetLastError();
        grid = cus * per_cu;
    }
    if (grid < 0) return;
    if (hipMemsetAsync(d_ws, 0, 65536, stream) != hipSuccess) { fprintf(stderr, "kernel_launch: memset of barrier words failed\n"); return; }
    Args a{};
    for (int i = 0; i < 33; ++i) a.in[i] = (const float*)d_in[i];
    a.out = (float*)d_out; a.ws = (unsigned char*)d_ws;
    void* kargs[] = {&a};
    hipError_t e = hipLaunchCooperativeKernel((const void*)fwd_megakernel, dim3(grid), dim3(NWAVES * 64), kargs, LDS_BYTES, stream);
    if (e != hipSuccess) fprintf(stderr, "cooperative launch failed: %s (grid %d)\n", hipGetErrorString(e), grid);
}
```

```cpp
#include <hip/hip_runtime.h>
#include <hip/hip_cooperative_groups.h>
#include <cstdio>
#include <cstdint>
namespace cg = cooperative_groups;
namespace pg8 {
#define PG8_LAS __attribute__((address_space(3)))
typedef unsigned short bf16_t;
typedef short bf16x8 __attribute__((ext_vector_type(8)));
typedef float f32x4 __attribute__((ext_vector_type(4)));
typedef unsigned u32x4 __attribute__((ext_vector_type(4)));
constexpr int BM = 256, BK = 64, HALF = 128, HTB = HALF * BK * 2  , STAGE_BYTES = 8 * HTB, NXCD = 8, WGM = 8;

__host__ __device__ __forceinline__ int lds_byte(int r, int c) { const int st = (r >> 4) * 2 + (c >> 5), rr = r & 15, cc = c & 31, ob = rr * 64 + cc * 2; return st * 1024 + (ob ^ (((ob >> 9) & 1) << 5)); }
__host__ __device__ __forceinline__ void stage_rc(int b, int& R, int& C) { const int st = b / 1024, sb = b % 1024, swz = sb ^ (((sb >> 9) & 1) << 5); R = (st >> 1) * 16 + swz / 64; C = (st & 1) * 32 + (swz % 64) / 2; }
__host__ __device__ __forceinline__ int perm32(int rho) { const int n = rho >> 4, i = rho & 15; return 8 * (i >> 2) + 4 * n + (i & 3); }

struct Unit { int pm, pn; };
struct Gemm { const bf16_t* A; const bf16_t* Bt; int M, N, K, lda; };

struct StaticOrder {
    int nM, nN, nwg, G, c;
    __host__ __device__ void init(int M, int N, int G_, int c_) { nM = M / BM; nN = N / BM; nwg = nM * nN; G = G_; c = c_; }
    __host__ __device__ bool next(int i, Unit& u) const {
        const long L = (long)i * G + c; if (L >= nwg) return false;
        int wgid = (int)L; { const int q = nwg / NXCD, r = nwg % NXCD, xcd = wgid % NXCD, off = wgid / NXCD; wgid = (xcd < r ? xcd * (q + 1) : r * (q + 1) + (xcd - r) * q) + off; }
        const int nig = WGM * nN, gid = wgid / nig, fm = gid * WGM, gsz = (nM - fm) < WGM ? (nM - fm) : WGM;
        u.pm = fm + ((wgid % nig) % gsz); u.pn = (wgid % nig) / gsz; return true;
    }
    __device__ __forceinline__ void a_ready(const Unit&) const {}
    __device__ __forceinline__ void done(const Unit&) const {}
};

__device__ __forceinline__ unsigned cvt_pk_bf16(float lo, float hi) { unsigned r; asm volatile("v_cvt_pk_bf16_f32 %0, %1, %2" : "=v"(r) : "v"(lo), "v"(hi)); return r; }
typedef float f32x2 __attribute__((ext_vector_type(2)));
__device__ __forceinline__ float rstd_from(const float* ps, int row, int off4, int n4, float inv_dim, int fq) {
    float s = 0.f;
    if (fq < n4) { const f32x4 v = *((const f32x4*)(ps + (size_t)row * 16) + off4 + fq); s = (v[0] + v[1]) + (v[2] + v[3]); }
    s += __shfl_xor(s, 16); s += __shfl_xor(s, 32);
    return rsqrtf(s * inv_dim + 1e-6f);
}
struct EpiSwiglu {
    static constexpr bool PERM = true, AFTER_DRAIN = false;
    bf16_t* H; const float* ps;
    __device__ __forceinline__ void operator()(const f32x4 (&acc)[2][2][4][2], const Unit& u, int wr, int wc, int fr, int fq) const {
        const int row0 = u.pm * BM + wr * 64 + fr, col0 = u.pn * 128 + wc * 32 + 8 * fq;
#pragma unroll
        for (int ai = 0; ai < 2; ++ai)
#pragma unroll
            for (int m = 0; m < 4; ++m) {
                const int row = row0 + ai * HALF + m * 16;
                const float rs = rstd_from(ps, row, 0, 4, 1.f / 1024.f, fq);
                float hv[8];
#pragma unroll
                for (int n = 0; n < 2; ++n)
#pragma unroll
                    for (int e = 0; e < 4; ++e) { const float gt = acc[ai][0][m][n][e] * rs, up = acc[ai][1][m][n][e] * rs;
                        hv[n * 4 + e] = gt * __builtin_amdgcn_rcpf(1.f + __builtin_amdgcn_exp2f(-1.4426950408889634f * gt)) * up; }
                u32x4 w; w.x = cvt_pk_bf16(hv[0], hv[1]); w.y = cvt_pk_bf16(hv[2], hv[3]); w.z = cvt_pk_bf16(hv[4], hv[5]); w.w = cvt_pk_bf16(hv[6], hv[7]);
                *(u32x4*)(H + (size_t)row * 2816 + col0) = w;
            }
    }
};
struct EpiRes {
    static constexpr bool PERM = true, AFTER_DRAIN = false;
    float* OUT; bf16_t* XB; float* ps; float alpha;
    __device__ __forceinline__ void operator()(const f32x4 (&acc)[2][2][4][2], const Unit& u, int wr, int wc, int fr, int fq) const {
        const int row0 = u.pm * BM + wr * 64 + fr, col0 = u.pn * BM + wc * 32 + 8 * fq;
#pragma unroll
        for (int ai = 0; ai < 2; ++ai)
#pragma unroll
            for (int m = 0; m < 4; ++m) {
                const int row = row0 + ai * HALF + m * 16;
                bf16_t* xb = XB + (size_t)row * 1024 + col0; float ss = 0.f;
#pragma unroll
                for (int bj = 0; bj < 2; ++bj) {
                    const u32x4 xw = *(const u32x4*)(xb + bj * HALF);
                    f32x4 x0, x1;
                    x0[0] = __uint_as_float(xw.x << 16); x0[1] = __uint_as_float(xw.x & 0xffff0000u); x0[2] = __uint_as_float(xw.y << 16); x0[3] = __uint_as_float(xw.y & 0xffff0000u);
                    x1[0] = __uint_as_float(xw.z << 16); x1[1] = __uint_as_float(xw.z & 0xffff0000u); x1[2] = __uint_as_float(xw.w << 16); x1[3] = __uint_as_float(xw.w & 0xffff0000u);
                    x0 = x0 + acc[ai][bj][m][0] * alpha; x1 = x1 + acc[ai][bj][m][1] * alpha;
                    if (OUT) { float* xr = OUT + (size_t)row * 1024 + col0 + bj * HALF; *(f32x4*)xr = x0; *(f32x4*)(xr + 4) = x1; }
                    else {
                        u32x4 w; w.x = cvt_pk_bf16(x0[0], x0[1]); w.y = cvt_pk_bf16(x0[2], x0[3]); w.z = cvt_pk_bf16(x1[0], x1[1]); w.w = cvt_pk_bf16(x1[2], x1[3]);
                        *(u32x4*)(xb + bj * HALF) = w;
                        ss += (x0[0] * x0[0] + x0[1] * x0[1]) + (x0[2] * x0[2] + x0[3] * x0[3]) + (x1[0] * x1[0] + x1[1] * x1[1]) + (x1[2] * x1[2] + x1[3] * x1[3]);
                    }
                }
                if (!OUT) { ss += __shfl_xor(ss, 16); ss += __shfl_xor(ss, 32); if (fq == 0) ps[(size_t)row * 16 + u.pn * 4 + wc] = ss; }
            }
    }
};
struct EpiBf16 {
    static constexpr bool PERM = true, AFTER_DRAIN = false;
    bf16_t* O; bf16_t* O2; int ldc; const float* ps_in; int off4, n4; float inv_dim; float* ps_out; int mode; const float* gq; const float* gk; int nq, nke;
    __device__ __forceinline__ void operator()(const f32x4 (&acc)[2][2][4][2], const Unit& u, int wr, int wc, int fr, int fq) const {
        const int row0 = u.pm * BM + wr * 64 + fr, col0 = u.pn * BM + wc * 32 + 8 * fq;
        if (mode == 3) {
            const int t6 = u.pn % 6, ttype = t6 < nq ? 0 : (t6 < nke ? 1 : 2);
            float gv[2][8];
#pragma unroll
            for (int bj = 0; bj < 2; ++bj)
#pragma unroll
                for (int j = 0; j < 8; ++j) gv[bj][j] = ttype == 0 ? gq[32 * bj + 8 * fq + j] * (0.125f * 1.4426950408889634f) : (ttype == 1 ? gk[32 * bj + 8 * fq + j] : 1.f);
            const int colo = u.pn * BM + 64 * wc + 8 * fq;
#pragma unroll
            for (int ai = 0; ai < 2; ++ai)
#pragma unroll
                for (int m = 0; m < 4; ++m) {
                    const int row = row0 + ai * HALF + m * 16;
                    const float rs = rstd_from(ps_in, row, off4, n4, inv_dim, fq);
                    f32x4 v[2][2]; float ss = 0.f;
#pragma unroll
                    for (int bj = 0; bj < 2; ++bj) { v[bj][0] = acc[ai][bj][m][0] * rs; v[bj][1] = acc[ai][bj][m][1] * rs;
                        ss += (v[bj][0][0] * v[bj][0][0] + v[bj][0][1] * v[bj][0][1]) + (v[bj][0][2] * v[bj][0][2] + v[bj][0][3] * v[bj][0][3]) + (v[bj][1][0] * v[bj][1][0] + v[bj][1][1] * v[bj][1][1]) + (v[bj][1][2] * v[bj][1][2] + v[bj][1][3] * v[bj][1][3]); }
                    ss += __shfl_xor(ss, 16); ss += __shfl_xor(ss, 32);
                    const float rh = ttype < 2 ? rsqrtf(ss * (1.f / 64.f) + 1e-6f) : 1.f;
#pragma unroll
                    for (int bj = 0; bj < 2; ++bj) {
                        u32x4 w; w.x = cvt_pk_bf16(v[bj][0][0] * rh * gv[bj][0], v[bj][0][1] * rh * gv[bj][1]); w.y = cvt_pk_bf16(v[bj][0][2] * rh * gv[bj][2], v[bj][0][3] * rh * gv[bj][3]);
                        w.z = cvt_pk_bf16(v[bj][1][0] * rh * gv[bj][4], v[bj][1][1] * rh * gv[bj][5]); w.w = cvt_pk_bf16(v[bj][1][2] * rh * gv[bj][6], v[bj][1][3] * rh * gv[bj][7]);
                        *(u32x4*)(O + (size_t)row * ldc + colo + 32 * bj) = w;
                    }
                }
            return;
        }
#pragma unroll
        for (int ai = 0; ai < 2; ++ai)
#pragma unroll
            for (int m = 0; m < 4; ++m) {
                const int row = row0 + ai * HALF + m * 16;
                const float rs = rstd_from(ps_in, row, off4, n4, inv_dim, fq); float ss = 0.f;
#pragma unroll
                for (int bj = 0; bj < 2; ++bj) {
                    const f32x4 v0 = acc[ai][bj][m][0] * rs, v1 = acc[ai][bj][m][1] * rs; const int colg = col0 + bj * HALF;
                    bf16_t* dst;
                    if (mode == 2) { const int hh = colg >> 7, d = colg & 127; dst = d < 64 ? O + (size_t)row * 1536 + hh * 96 + d : O2 + (size_t)row * 1024 + hh * 64 + (d - 64); }
                    else dst = O + (size_t)row * ldc + colg;
                    u32x4 w; w.x = cvt_pk_bf16(v0[0], v0[1]); w.y = cvt_pk_bf16(v0[2], v0[3]); w.z = cvt_pk_bf16(v1[0], v1[1]); w.w = cvt_pk_bf16(v1[2], v1[3]);
                    *(u32x4*)dst = w;
                    ss += (v0[0] * v0[0] + v0[1] * v0[1]) + (v0[2] * v0[2] + v0[3] * v0[3]) + (v1[0] * v1[0] + v1[1] * v1[1]) + (v1[2] * v1[2] + v1[3] * v1[3]);
                }
                if (mode == 1) { ss += __shfl_xor(ss, 16); ss += __shfl_xor(ss, 32); if (fq == 0) ps_out[(size_t)row * 16 + u.pn * 4 + wc] = ss; }
            }
    }
};

template <class Epi, class Sched, bool ALIGN_EPI = false, bool SP2 = false>
__device__ __forceinline__ void gemm_phase(PG8_LAS unsigned char* lds, const Gemm g, const Sched& S, const Epi& E) {
    int tid_o = threadIdx.x; asm volatile("" : "+v"(tid_o));
    const int tid = tid_o, wid = __builtin_amdgcn_readfirstlane(tid >> 6), lane = tid & 63, wr = wid >> 2, wc = wid & 3, fr = lane & 15, fq = lane >> 4;
    const int K = g.K, nt = K / BK;
    unsigned voffA[2], voffB[2];
#pragma unroll
    for (int i = 0; i < 2; ++i) { int R, C; stage_rc(tid * 16 + i * 8192, R, C); const int Rb = Epi::PERM ? ((R & ~31) + perm32(R & 31)) : R;
        voffA[i] = (unsigned)(R * g.lda + C) * 2u; voffB[i] = (unsigned)(Rb * K + C) * 2u; }
    const size_t kstep = (size_t)(BK * 2);
    const size_t hstep = (size_t)HALF * K * 2;
    const size_t tstep = 2 * hstep; const size_t hstepA = (size_t)HALF * g.lda * 2, tstepA = 2 * hstepA;
    const unsigned ldsw = (unsigned)wid * 1024u;
    const int aoff = lds_byte(wr * 64 + fr, fq * 8), boff = lds_byte(wc * 32 + fr, fq * 8);
#define PG8_SA(b, h) (((b) * 2 + (h)) * HTB)
#define PG8_SB(b, h) ((4 + (b) * 2 + (h)) * HTB)
#define PG8_STAGE(bufoff, gbase, voff) do { _Pragma("unroll") for (int _i = 0; _i < 2; ++_i) \
        __builtin_amdgcn_global_load_lds((const unsigned*)((const char*)(gbase) + (voff)[_i]), (PG8_LAS unsigned*)(lds + (bufoff) + ldsw + _i * 8192), 16, 0, 0); } while (0)
#define PG8_LDA(dst, b, h) do { _Pragma("unroll") for (int m = 0; m < 4; ++m) _Pragma("unroll") for (int k = 0; k < 2; ++k) dst[m][k] = *(const PG8_LAS bf16x8*)(lds + PG8_SA(b, h) + aoff + m * 2048 + k * 1024); } while (0)
#define PG8_LDB(dst, b, h) do { _Pragma("unroll") for (int n = 0; n < 2; ++n) _Pragma("unroll") for (int k = 0; k < 2; ++k) dst[n][k] = *(const PG8_LAS bf16x8*)(lds + PG8_SB(b, h) + boff + n * 2048 + k * 1024); } while (0)
#define PG8_MMA(ai, bj, At, Bt) do { __builtin_amdgcn_s_setprio(1); _Pragma("unroll") for (int m = 0; m < 4; ++m) _Pragma("unroll") for (int n = 0; n < 2; ++n) _Pragma("unroll") for (int k = 0; k < 2; ++k) \
        acc[ai][bj][m][n] = __builtin_amdgcn_mfma_f32_16x16x32_bf16(Bt[n][k], At[m][k], acc[ai][bj][m][n], 0, 0, 0); __builtin_amdgcn_s_setprio(0); } while (0)
#define PG8_WAIT_V(n) asm volatile("s_waitcnt vmcnt(" #n ")" ::: "memory")
#define PG8_WAIT_L(n) asm volatile("s_waitcnt lgkmcnt(" #n ")" ::: "memory")
#define PG8_BAR __builtin_amdgcn_s_barrier()
#define PG8_SCHED __builtin_amdgcn_sched_barrier(0)
    Unit cur, nxt; int ui = 0;
    if (!S.next(0, cur)) return;
    f32x4 acc[2][2][4][2];
#pragma unroll
    for (int a = 0; a < 2; ++a)
#pragma unroll
        for (int b = 0; b < 2; ++b)
#pragma unroll
            for (int m = 0; m < 4; ++m)
#pragma unroll
                for (int n = 0; n < 2; ++n) acc[a][b][m][n] = (f32x4){0.f, 0.f, 0.f, 0.f};
    bf16x8 At[4][2], B0[2][2], B1[2][2];
    const char* cA = (const char*)g.A + (size_t)cur.pm * tstepA; const char* cB = (const char*)g.Bt + (size_t)cur.pn * tstep;
    S.a_ready(cur);
    if constexpr (SP2) {
        PG8_STAGE(PG8_SB(0, 0), cB, voffB); PG8_STAGE(PG8_SB(0, 1), cB + hstep, voffB); PG8_STAGE(PG8_SA(0, 0), cA, voffA); PG8_STAGE(PG8_SA(0, 1), cA + hstepA, voffA);
        if (wr == 1) PG8_BAR;
        PG8_WAIT_V(2); PG8_BAR;
        PG8_STAGE(PG8_SB(1, 0), cB + kstep, voffB); PG8_STAGE(PG8_SA(1, 0), cA + kstep, voffA); PG8_STAGE(PG8_SB(1, 1), cB + hstep + kstep, voffB);
        PG8_WAIT_V(6); PG8_BAR;
    } else {
        PG8_STAGE(PG8_SB(0, 0), cB, voffB); PG8_STAGE(PG8_SA(0, 0), cA, voffA); PG8_STAGE(PG8_SB(0, 1), cB + hstep, voffB); PG8_STAGE(PG8_SA(0, 1), cA + hstepA, voffA);
        if (wr == 1) PG8_BAR;
        PG8_WAIT_V(4); PG8_BAR;
        PG8_STAGE(PG8_SB(1, 0), cB + kstep, voffB); PG8_STAGE(PG8_SA(1, 0), cA + kstep, voffA); PG8_STAGE(PG8_SB(1, 1), cB + hstep + kstep, voffB);
        PG8_WAIT_V(6); PG8_BAR;
    }
    for (;;) {
        const bool has_next = S.next(ui + 1, nxt);
        const char* nA = has_next ? (const char*)g.A + (size_t)nxt.pm * tstepA : cA; const char* nB = has_next ? (const char*)g.Bt + (size_t)nxt.pn * tstep : cB;
        for (int t = 0; t < nt; t += 2) {
            const bool last = (t == nt - 2);
            const char* a1 = cA + (size_t)(t + 1) * kstep;
            const char* a2 = last ? nA : cA + (size_t)(t + 2) * kstep; const char* b2 = last ? nB : cB + (size_t)(t + 2) * kstep;
            const char* a3 = a2 + kstep; const char* b3 = b2 + kstep;
            if (last && has_next) S.a_ready(nxt);
            if constexpr (SP2) {
            PG8_LDB(B0, 0, 0); PG8_LDB(B1, 0, 1); PG8_SCHED; PG8_LDA(At, 0, 0); PG8_STAGE(PG8_SA(1, 1), a1 + hstepA, voffA);
            PG8_WAIT_V(8); PG8_WAIT_L(0); PG8_BAR; PG8_MMA(0, 0, At, B0); PG8_MMA(0, 1, At, B1); PG8_BAR; PG8_SCHED;
            PG8_LDA(At, 0, 1); PG8_STAGE(PG8_SB(0, 0), b2, voffB); PG8_STAGE(PG8_SB(0, 1), b2 + hstep, voffB); PG8_STAGE(PG8_SA(0, 0), a2, voffA);
            PG8_WAIT_V(8); PG8_WAIT_L(0); PG8_BAR; PG8_MMA(1, 0, At, B0); PG8_MMA(1, 1, At, B1); PG8_BAR; PG8_SCHED;
            PG8_LDB(B0, 1, 0); PG8_LDB(B1, 1, 1); PG8_SCHED; PG8_LDA(At, 1, 0); PG8_STAGE(PG8_SA(0, 1), a2 + hstepA, voffA);
            PG8_WAIT_V(8); PG8_WAIT_L(0); PG8_BAR; PG8_MMA(0, 0, At, B0); PG8_MMA(0, 1, At, B1); PG8_BAR; PG8_SCHED;
            PG8_LDA(At, 1, 1); PG8_STAGE(PG8_SB(1, 0), b3, voffB); PG8_STAGE(PG8_SB(1, 1), b3 + hstep, voffB); PG8_STAGE(PG8_SA(1, 0), a3, voffA);
            PG8_WAIT_V(8); PG8_WAIT_L(0); PG8_BAR; PG8_MMA(1, 0, At, B0); PG8_MMA(1, 1, At, B1); PG8_BAR; PG8_SCHED;
            } else {
            PG8_LDB(B0, 0, 0); PG8_SCHED; PG8_LDA(At, 0, 0); PG8_STAGE(PG8_SA(1, 1), a1 + hstepA, voffA);
            PG8_WAIT_L(8); PG8_BAR; PG8_WAIT_L(0); PG8_MMA(0, 0, At, B0); PG8_BAR; PG8_SCHED;
            PG8_LDB(B1, 0, 1); PG8_STAGE(PG8_SB(0, 0), b2, voffB);
            PG8_BAR; PG8_WAIT_L(0); PG8_MMA(0, 1, At, B1); PG8_BAR;
            PG8_LDA(At, 0, 1); PG8_STAGE(PG8_SA(0, 0), a2, voffA);
            PG8_BAR; PG8_WAIT_L(0); PG8_MMA(1, 0, At, B0); PG8_BAR; PG8_SCHED;
            PG8_STAGE(PG8_SB(0, 1), b2 + hstep, voffB);
            PG8_WAIT_V(6); PG8_BAR; PG8_MMA(1, 1, At, B1); PG8_BAR;
            PG8_LDB(B0, 1, 0); PG8_SCHED; PG8_LDA(At, 1, 0); PG8_STAGE(PG8_SA(0, 1), a2 + hstepA, voffA);
            PG8_WAIT_L(8); PG8_BAR; PG8_WAIT_L(0); PG8_MMA(0, 0, At, B0); PG8_BAR; PG8_SCHED;
            PG8_LDB(B1, 1, 1); PG8_STAGE(PG8_SB(1, 0), b3, voffB);
            PG8_BAR; PG8_WAIT_L(0); PG8_MMA(0, 1, At, B1); PG8_BAR;
            PG8_LDA(At, 1, 1); PG8_STAGE(PG8_SA(1, 0), a3, voffA);
            PG8_BAR; PG8_WAIT_L(0); PG8_MMA(1, 0, At, B0); PG8_BAR; PG8_SCHED;
            PG8_STAGE(PG8_SB(1, 1), b3 + hstep, voffB);
            PG8_WAIT_V(6); PG8_BAR; PG8_MMA(1, 1, At, B1); PG8_BAR;
            }
        }
        if constexpr (ALIGN_EPI) { if (wr == 0) PG8_BAR; }
        if constexpr (!Epi::AFTER_DRAIN) { E(acc, cur, wr, wc, fr, fq); S.done(cur); }
        if (!has_next) break;
#pragma unroll
        for (int a = 0; a < 2; ++a)
#pragma unroll
            for (int b = 0; b < 2; ++b)
#pragma unroll
                for (int m = 0; m < 4; ++m)
#pragma unroll
                    for (int n = 0; n < 2; ++n) acc[a][b][m][n] = (f32x4){0.f, 0.f, 0.f, 0.f};
        cur = nxt; cA = nA; cB = nB; ++ui;
        if constexpr (ALIGN_EPI) { if (wr == 1) PG8_BAR; }
    }
    PG8_WAIT_V(0);
    if constexpr (!ALIGN_EPI) { if (wr == 0) PG8_BAR; }
    PG8_BAR;
    if constexpr (Epi::AFTER_DRAIN) { E.fused(acc, cur, wr, wc, fr, fq, lds, wid, lane); S.done(cur); }
#undef PG8_SA
#undef PG8_SB
#undef PG8_STAGE
#undef PG8_LDA
#undef PG8_LDB
#undef PG8_MMA
#undef PG8_WAIT_V
#undef PG8_WAIT_L
#undef PG8_BAR
#undef PG8_SCHED
}
}
namespace att {
using pg8::bf16_t; using pg8::bf16x8; using pg8::f32x4; using pg8::u32x4;
typedef float f32x16 __attribute__((ext_vector_type(16)));
typedef short s16x4 __attribute__((ext_vector_type(4)));
typedef float f32x2_t __attribute__((ext_vector_type(2))); typedef __bf16 bf16x2_t __attribute__((ext_vector_type(2)));
#define ALAS __attribute__((address_space(3)))
constexpr float LOG2E = 1.4426950408889634f, LN2 = 0.6931471805599453f;
__device__ __forceinline__ unsigned cvtpk(float lo, float hi) { f32x2_t v = {lo, hi}; bf16x2_t b = __builtin_convertvector(v, bf16x2_t); return __builtin_bit_cast(unsigned, b); }
__device__ __forceinline__ float fadd_s(float a, float b) { float r; asm("v_add_f32_e32 %0, %1, %2" : "=v"(r) : "v"(a), "v"(b)); return r; }
__device__ __forceinline__ int crow(int i, int h) { return (i & 3) + 8 * (i >> 2) + 4 * h; }
__device__ __forceinline__ s16x4 vtr(const ALAS unsigned char* p) { return __builtin_bit_cast(s16x4, __builtin_amdgcn_ds_read_tr16_b64_v4i16((ALAS s16x4*)p)); }
#define AMFMA(a, b, c) __builtin_amdgcn_mfma_f32_32x32x16_bf16((a), (b), (c), 0, 0, 0)

struct AU {
    const bf16_t* Q; const bf16_t* K; const bf16_t* V; bf16_t* O; float* lse; const float* sink;
    long qrs, krs, vrs, ors, lrs;
    int q0, nsub, wph, qhs, ohs, band, hq0; float sl_scale, sl_exp; int r2;
};

__device__ __forceinline__ void attn_unit_r2(const AU& u, ALAS unsigned char* lds, float mb2) {
    constexpr int KP = 144, VP = 144, KBUF = 64 * KP, VBUF = 64 * VP, V_OFF = 2 * KBUF;
    int tid_o = threadIdx.x; asm volatile("" : "+v"(tid_o));
    const int tid = tid_o, lane = tid & 63, wid = __builtin_amdgcn_readfirstlane(tid >> 6), r = lane & 31, h = lane >> 5;
    const int hl = wid / u.wph, qs = u.q0 + 64 * (wid % u.wph);
    bf16x8 qa[4], qb[4];
    { const bf16_t* qp = u.Q + (size_t)hl * u.qhs + (size_t)(qs + r) * u.qrs + h * 8;
#pragma unroll
      for (int d0 = 0; d0 < 4; ++d0) { qa[d0] = *(const bf16x8*)(qp + d0 * 16); qb[d0] = *(const bf16x8*)(qp + (size_t)32 * u.qrs + d0 * 16); } }
    const int NT = u.nsub >> 6;
    const int kr0 = tid >> 3, kc0 = tid & 7;
    const bf16_t* kg0 = u.K + (size_t)kr0 * u.krs + kc0 * 8; const bf16_t* vg = u.V + (size_t)kr0 * u.vrs + kc0 * 8;
    const int kl0 = kr0 * KP + kc0 * 16, vl = V_OFF + kr0 * VP + kc0 * 16;
    f32x16 oa0, oa1, ob0, ob1, negm;
#pragma unroll
    for (int i = 0; i < 16; ++i) { oa0[i] = 0.f; oa1[i] = 0.f; ob0[i] = 0.f; ob1[i] = 0.f; negm[i] = -mb2; }
    float la = 0.f, lb = 0.f;
    u32x4 rk = *(const u32x4*)kg0, rv = *(const u32x4*)vg;
    *(ALAS u32x4*)(lds + kl0) = rk; *(ALAS u32x4*)(lds + vl) = rv;
    __syncthreads();
    for (int t = 0; t < NT; ++t) {
        const int cur = t & 1;
        if (t + 1 < NT) { const size_t ro = (size_t)(t + 1) * 64; rk = *(const u32x4*)(kg0 + ro * u.krs); rv = *(const u32x4*)(vg + ro * u.vrs); }
        {
            const ALAS unsigned char* kb = lds + cur * KBUF + r * KP + h * 16;
            const ALAS unsigned char* vb = lds + V_OFF + cur * VBUF + (4 * h + ((lane & 15) >> 2)) * VP + ((lane >> 4) & 1) * 32 + (lane & 3) * 8;
            f32x16 Sa0 = negm, Sa1 = negm, Sb0 = negm, Sb1 = negm;
#pragma unroll
            for (int d0 = 0; d0 < 4; ++d0) {
                const bf16x8 k0 = *(const ALAS bf16x8*)(kb + d0 * 32), k1 = *(const ALAS bf16x8*)(kb + 32 * KP + d0 * 32);
                Sa0 = AMFMA(k0, qa[d0], Sa0); Sa1 = AMFMA(k1, qa[d0], Sa1); Sb0 = AMFMA(k0, qb[d0], Sb0); Sb1 = AMFMA(k1, qb[d0], Sb1);
            }
            bf16x8 paa[4], pab[4];
#define R2_SOFT(S0_, S1_, PA_, L_) do { float s0_ = 0.f, s1_ = 0.f; \
                _Pragma("unroll") for (int i = 0; i < 16; ++i) { S0_[i] = __builtin_amdgcn_exp2f(S0_[i]); S1_[i] = __builtin_amdgcn_exp2f(S1_[i]); } \
                __builtin_amdgcn_sched_barrier(0);     \
                _Pragma("unroll") for (int i = 0; i < 16; ++i) { s0_ += S0_[i]; s1_ += S1_[i]; } \
                L_ += s0_ + s1_; u32x4 w_; \
                w_.x = cvtpk(S0_[0], S0_[1]); w_.y = cvtpk(S0_[2], S0_[3]); w_.z = cvtpk(S0_[4], S0_[5]); w_.w = cvtpk(S0_[6], S0_[7]); PA_[0] = __builtin_bit_cast(bf16x8, w_); \
                w_.x = cvtpk(S0_[8], S0_[9]); w_.y = cvtpk(S0_[10], S0_[11]); w_.z = cvtpk(S0_[12], S0_[13]); w_.w = cvtpk(S0_[14], S0_[15]); PA_[1] = __builtin_bit_cast(bf16x8, w_); \
                w_.x = cvtpk(S1_[0], S1_[1]); w_.y = cvtpk(S1_[2], S1_[3]); w_.z = cvtpk(S1_[4], S1_[5]); w_.w = cvtpk(S1_[6], S1_[7]); PA_[2] = __builtin_bit_cast(bf16x8, w_); \
                w_.x = cvtpk(S1_[8], S1_[9]); w_.y = cvtpk(S1_[10], S1_[11]); w_.z = cvtpk(S1_[12], S1_[13]); w_.w = cvtpk(S1_[14], S1_[15]); PA_[3] = __builtin_bit_cast(bf16x8, w_); } while (0)
            R2_SOFT(Sa0, Sa1, paa, la);
            R2_SOFT(Sb0, Sb1, pab, lb);
#undef R2_SOFT
#pragma unroll
            for (int ks = 0; ks < 4; ++ks) {
                const s16x4 lo0 = vtr(vb + ks * 16 * VP), hi0 = vtr(vb + (ks * 16 + 8) * VP), lo1 = vtr(vb + ks * 16 * VP + 64), hi1 = vtr(vb + (ks * 16 + 8) * VP + 64);
                const bf16x8 vf0 = __builtin_shufflevector(lo0, hi0, 0, 1, 2, 3, 4, 5, 6, 7), vf1 = __builtin_shufflevector(lo1, hi1, 0, 1, 2, 3, 4, 5, 6, 7);
                oa0 = AMFMA(paa[ks], vf0, oa0); oa1 = AMFMA(paa[ks], vf1, oa1); ob0 = AMFMA(pab[ks], vf0, ob0); ob1 = AMFMA(pab[ks], vf1, ob1);
            }
        }
        if (t + 1 < NT) { *(ALAS u32x4*)(lds + (cur ^ 1) * KBUF + kl0) = rk; *(ALAS u32x4*)(lds + (cur ^ 1) * VBUF + vl) = rv; }
        __syncthreads();
    }
    la += __shfl_xor(la, 32); lb += __shfl_xor(lb, 32);
    const float ia = 1.f / la, ib = 1.f / lb;
    bf16_t* op = u.O + (size_t)hl * u.ohs + r;
#pragma unroll
    for (int i = 0; i < 16; ++i) { const int qi = crow(i, h); const float fa = __shfl(ia, qi), fb = __shfl(ib, qi);
        bf16_t* ra = op + (size_t)(qs + qi) * u.ors; bf16_t* rb = op + (size_t)(qs + 32 + qi) * u.ors;
        ra[0] = (bf16_t)(cvtpk(oa0[i] * fa, 0.f) & 0xffffu); ra[32] = (bf16_t)(cvtpk(oa1[i] * fa, 0.f) & 0xffffu);
        rb[0] = (bf16_t)(cvtpk(ob0[i] * fb, 0.f) & 0xffffu); rb[32] = (bf16_t)(cvtpk(ob1[i] * fb, 0.f) & 0xffffu);
        if ((i & 3) == 3) asm volatile("s_waitcnt vmcnt(0)" ::: "memory"); }
}

template <bool SUB> __device__ __forceinline__ void attn_unit_r2b(const AU& u, ALAS unsigned char* lds, float mb2) {
    constexpr int KP = 208, VP = 144, KBUF = 64 * KP, VBUF = 64 * VP, V_OFF = 2 * KBUF, QB_OFF = V_OFF + 2 * VBUF;
    int tid_o = threadIdx.x; asm volatile("" : "+v"(tid_o));
    const int tid = tid_o, lane = tid & 63, wid = __builtin_amdgcn_readfirstlane(tid >> 6), r = lane & 31, h = lane >> 5;
    const int qs = u.q0 + 64 * wid;
    bf16x8 qa[6];
    ALAS unsigned char* qbl = lds + QB_OFF + wid * 6144 + lane * 16;
    { const bf16_t* qp = u.Q + (size_t)(qs + r) * u.qrs + h * 8;
#pragma unroll
      for (int d0 = 0; d0 < 6; ++d0) { qa[d0] = *(const bf16x8*)(qp + d0 * 16); const bf16x8 t_ = *(const bf16x8*)(qp + (size_t)32 * u.qrs + d0 * 16); *(ALAS bf16x8*)(qbl + d0 * 1024) = t_; } }
    const int NT = u.nsub >> 6;
    const int kr0 = tid / 12, kc0 = tid - kr0 * 12, c1 = tid + 512, kr1 = c1 / 12, kc1 = c1 - kr1 * 12, vr_ = tid >> 3, vc_ = tid & 7;
    const bool k2 = tid < 256;
    const bf16_t* kg0 = u.K + (size_t)kr0 * u.krs + kc0 * 8; const bf16_t* kg1 = u.K + (size_t)kr1 * u.krs + kc1 * 8; const bf16_t* vg = u.V + (size_t)vr_ * u.vrs + vc_ * 8;
    const int kl0 = kr0 * KP + kc0 * 16, kl1 = kr1 * KP + kc1 * 16, vl = V_OFF + vr_ * VP + vc_ * 16;
    f32x16 oa0, oa1, ob0, ob1;
#pragma unroll
    for (int i = 0; i < 16; ++i) { oa0[i] = 0.f; oa1[i] = 0.f; ob0[i] = 0.f; ob1[i] = 0.f; }
    float la = 0.f, lb = 0.f;
    u32x4 rk0 = *(const u32x4*)kg0, rk1 = (u32x4){0u, 0u, 0u, 0u}, rv = *(const u32x4*)vg;
    if (k2) rk1 = *(const u32x4*)kg1;
    *(ALAS u32x4*)(lds + kl0) = rk0; if (k2) *(ALAS u32x4*)(lds + kl1) = rk1; *(ALAS u32x4*)(lds + vl) = rv;
    __syncthreads();
    for (int t = 0; t < NT; ++t) {
        const int cur = t & 1;
        if (t + 1 < NT) { const size_t ro = (size_t)(t + 1) * 64; rk0 = *(const u32x4*)(kg0 + ro * u.krs); if (k2) rk1 = *(const u32x4*)(kg1 + ro * u.krs); rv = *(const u32x4*)(vg + ro * u.vrs); }
        {
            const ALAS unsigned char* kb = lds + cur * KBUF + r * KP + h * 16;
            const ALAS unsigned char* vb = lds + V_OFF + cur * VBUF + (4 * h + ((lane & 15) >> 2)) * VP + ((lane >> 4) & 1) * 32 + (lane & 3) * 8;
            bf16x8 paa[4], pab[4];
            f32x16 Sa0, Sa1, Sb0, Sb1;
#pragma unroll
            for (int i = 0; i < 16; ++i) { Sa0[i] = 0.f; Sa1[i] = 0.f; Sb0[i] = 0.f; Sb1[i] = 0.f; }
#pragma unroll
            for (int d0 = 0; d0 < 6; ++d0) {
                const bf16x8 k0 = *(const ALAS bf16x8*)(kb + d0 * 32), k1 = *(const ALAS bf16x8*)(kb + 32 * KP + d0 * 32); const bf16x8 qbv = *(const ALAS bf16x8*)(qbl + d0 * 1024);
                Sa0 = AMFMA(k0, qa[d0], Sa0); Sa1 = AMFMA(k1, qa[d0], Sa1); Sb0 = AMFMA(k0, qbv, Sb0); Sb1 = AMFMA(k1, qbv, Sb1);
                if (d0 & 1) __builtin_amdgcn_sched_barrier(0);
            }
#define R2B_SOFT(S0_, S1_, PA_, L_) do { float s0_ = 0.f, s1_ = 0.f; \
                _Pragma("unroll") for (int i = 0; i < 16; ++i) { S0_[i] = __builtin_amdgcn_exp2f(SUB ? S0_[i] - mb2 : S0_[i]); S1_[i] = __builtin_amdgcn_exp2f(SUB ? S1_[i] - mb2 : S1_[i]); } \
                _Pragma("unroll") for (int i = 0; i < 16; ++i) { s0_ += S0_[i]; s1_ += S1_[i]; } \
                L_ += s0_ + s1_; u32x4 w_; \
                w_.x = cvtpk(S0_[0], S0_[1]); w_.y = cvtpk(S0_[2], S0_[3]); w_.z = cvtpk(S0_[4], S0_[5]); w_.w = cvtpk(S0_[6], S0_[7]); PA_[0] = __builtin_bit_cast(bf16x8, w_); \
                w_.x = cvtpk(S0_[8], S0_[9]); w_.y = cvtpk(S0_[10], S0_[11]); w_.z = cvtpk(S0_[12], S0_[13]); w_.w = cvtpk(S0_[14], S0_[15]); PA_[1] = __builtin_bit_cast(bf16x8, w_); \
                w_.x = cvtpk(S1_[0], S1_[1]); w_.y = cvtpk(S1_[2], S1_[3]); w_.z = cvtpk(S1_[4], S1_[5]); w_.w = cvtpk(S1_[6], S1_[7]); PA_[2] = __builtin_bit_cast(bf16x8, w_); \
                w_.x = cvtpk(S1_[8], S1_[9]); w_.y = cvtpk(S1_[10], S1_[11]); w_.z = cvtpk(S1_[12], S1_[13]); w_.w = cvtpk(S1_[14], S1_[15]); PA_[3] = __builtin_bit_cast(bf16x8, w_); } while (0)
            R2B_SOFT(Sa0, Sa1, paa, la);
            __builtin_amdgcn_sched_barrier(0);
            R2B_SOFT(Sb0, Sb1, pab, lb);
#undef R2B_SOFT
#pragma unroll
            for (int ks = 0; ks < 4; ++ks) {
                const s16x4 lo0 = vtr(vb + ks * 16 * VP), hi0 = vtr(vb + (ks * 16 + 8) * VP), lo1 = vtr(vb + ks * 16 * VP + 64), hi1 = vtr(vb + (ks * 16 + 8) * VP + 64);
                const bf16x8 vf0 = __builtin_shufflevector(lo0, hi0, 0, 1, 2, 3, 4, 5, 6, 7), vf1 = __builtin_shufflevector(lo1, hi1, 0, 1, 2, 3, 4, 5, 6, 7);
                oa0 = AMFMA(paa[ks], vf0, oa0); oa1 = AMFMA(paa[ks], vf1, oa1); ob0 = AMFMA(pab[ks], vf0, ob0); ob1 = AMFMA(pab[ks], vf1, ob1);
            }
        }
        if (t + 1 < NT) { *(ALAS u32x4*)(lds + (cur ^ 1) * KBUF + kl0) = rk0; if (k2) *(ALAS u32x4*)(lds + (cur ^ 1) * KBUF + kl1) = rk1; *(ALAS u32x4*)(lds + (cur ^ 1) * VBUF + vl) = rv; }
        __syncthreads();
    }
    la += __shfl_xor(la, 32); lb += __shfl_xor(lb, 32);
    const float ia = 1.f / la, ib = 1.f / lb;
    bf16_t* op = u.O + r;
#pragma unroll
    for (int i = 0; i < 16; ++i) { const int qi = crow(i, h); const float fa = __shfl(ia, qi), fb = __shfl(ib, qi);
        bf16_t* ra = op + (size_t)(qs + qi) * u.ors; bf16_t* rb = op + (size_t)(qs + 32 + qi) * u.ors;
        ra[0] = (bf16_t)(cvtpk(oa0[i] * fa, 0.f) & 0xffffu); ra[32] = (bf16_t)(cvtpk(oa1[i] * fa, 0.f) & 0xffffu);
        rb[0] = (bf16_t)(cvtpk(ob0[i] * fb, 0.f) & 0xffffu); rb[32] = (bf16_t)(cvtpk(ob1[i] * fb, 0.f) & 0xffffu);
        if ((i & 3) == 3) asm volatile("s_waitcnt vmcnt(0)" ::: "memory"); }
}

template <int DQ> __device__ __forceinline__ void attn_unit(const AU& u, ALAS unsigned char* lds, float mb2) {
    if constexpr (DQ == 64) { if (u.r2) { attn_unit_r2(u, lds, mb2); return; } }
    if constexpr (DQ == 96) { if (u.r2) { if (mb2 > 64.f) attn_unit_r2b<true>(u, lds, mb2); else attn_unit_r2b<false>(u, lds, mb2); return; } }
    constexpr int KP = DQ * 2 + 16, VP = 144, NF = DQ / 16, CPR = DQ / 8, KBUF = 64 * KP, VBUF = 64 * VP, V_OFF = 2 * KBUF;
    int tid_o = threadIdx.x; asm volatile("" : "+v"(tid_o));
    const int tid = tid_o, lane = tid & 63, wid = __builtin_amdgcn_readfirstlane(tid >> 6), r = lane & 31, h = lane >> 5;
    const int hl = wid / u.wph, qs = u.q0 + 32 * (wid % u.wph);
    const bool wact = qs < u.nsub;
    bf16x8 qf[NF];
#pragma unroll
    for (int d0 = 0; d0 < NF; ++d0) qf[d0] = (bf16x8){0, 0, 0, 0, 0, 0, 0, 0};
    if (wact) { const bf16_t* qp = u.Q + (size_t)hl * u.qhs + (size_t)(qs + r) * u.qrs + h * 8;
#pragma unroll
        for (int d0 = 0; d0 < NF; ++d0) qf[d0] = *(const bf16x8*)(qp + d0 * 16); }
    const int RU = 32 * u.wph;
    int tlo = 0, thi = u.nsub >> 6;
    if (u.band) { const int a = u.q0 - u.band; tlo = a > 0 ? (a >> 6) : 0; const int b = ((u.q0 + RU - 1 + u.band) >> 6) + 1; thi = b < thi ? b : thi; }
    const float slope2 = u.sl_scale * exp2f(-u.sl_exp * (float)(u.hq0 + hl + 1));
    const int kr0 = tid / CPR, kc0 = tid - kr0 * CPR, c1 = tid + 512, kr1 = c1 / CPR, kc1 = c1 - kr1 * CPR;
    const bool k2 = (DQ == 96) && (tid < 256);
    const int vr_ = tid >> 3, vc_ = tid & 7;
    const bf16_t* kg0 = u.K + (size_t)kr0 * u.krs + kc0 * 8; const bf16_t* kg1 = u.K + (size_t)kr1 * u.krs + kc1 * 8; const bf16_t* vg = u.V + (size_t)vr_ * u.vrs + vc_ * 8;
    const int kl0 = kr0 * KP + kc0 * 16, kl1 = kr1 * KP + kc1 * 16, vl = V_OFF + vr_ * VP + vc_ * 16;
    f32x16 o0, o1, negm;
#pragma unroll
    for (int i = 0; i < 16; ++i) { o0[i] = 0.f; o1[i] = 0.f; negm[i] = -mb2; }
    float lsum = 0.f;
#define ATT_LOADK(t, S) do { const size_t ro_ = (size_t)(t) * 64; rk0##S = *(const u32x4*)(kg0 + ro_ * u.krs); if (k2) rk1##S = *(const u32x4*)(kg1 + ro_ * u.krs); } while (0)
#define ATT_LOADV(t, S) do { const size_t ro_ = (size_t)(t) * 64; rv##S = *(const u32x4*)(vg + ro_ * u.vrs); } while (0)
#define ATT_STOREK(b, S) do { *(ALAS u32x4*)(lds + (b) * KBUF + kl0) = rk0##S; if (k2) *(ALAS u32x4*)(lds + (b) * KBUF + kl1) = rk1##S; } while (0)
#define ATT_STOREV(b, S) do { *(ALAS u32x4*)(lds + (b) * VBUF + vl) = rv##S; } while (0)
#define ATT_SUMPACK4(X, B, PA) do { sacc = fadd_s(sacc, X[B]); sacc2 = fadd_s(sacc2, X[B + 1]); sacc = fadd_s(sacc, X[B + 2]); sacc2 = fadd_s(sacc2, X[B + 3]); sacc = fadd_s(sacc, X[B + 4]); sacc2 = fadd_s(sacc2, X[B + 5]); sacc = fadd_s(sacc, X[B + 6]); sacc2 = fadd_s(sacc2, X[B + 7]); \
        u32x4 w_; w_.x = cvtpk(X[B], X[B + 1]); w_.y = cvtpk(X[B + 2], X[B + 3]); w_.z = cvtpk(X[B + 4], X[B + 5]); w_.w = cvtpk(X[B + 6], X[B + 7]); PA = __builtin_bit_cast(bf16x8, w_); } while (0)
#define ATT_DENSE_BODY(t, P, Q) do { \
        if ((t) + 2 < NT) ATT_LOADK((t) + 2, P); if ((t) + 1 < NT) ATT_LOADV((t) + 1, Q); \
        if (wact) { \
            const ALAS unsigned char* kb = lds + (P) * KBUF + r * KP + h * 16; \
            const ALAS unsigned char* vb = lds + V_OFF + (Q) * VBUF + (4 * h + ((lane & 15) >> 2)) * VP + ((lane >> 4) & 1) * 32 + (lane & 3) * 8; \
            f32x16 S0 = negm, S1 = negm; bf16x8 pa[4]; float sacc = 0.f, sacc2 = 0.f; \
            _Pragma("unroll") for (int d0 = 0; d0 < NF; ++d0) { \
                const bf16x8 k0 = *(const ALAS bf16x8*)(kb + d0 * 32), k1 = *(const ALAS bf16x8*)(kb + 32 * KP + d0 * 32); \
                S0 = AMFMA(k0, qf[d0], S0); S1 = AMFMA(k1, qf[d0], S1); \
                if (d0 == 0) ATT_SUMPACK4(X0, 0, pa[0]); \
                if (d0 == 1) ATT_SUMPACK4(X0, 8, pa[1]); \
                if (d0 == 2) ATT_SUMPACK4(X1, 0, pa[2]); \
                if (d0 == 3) ATT_SUMPACK4(X1, 8, pa[3]); \
            } \
            lsum += sacc + sacc2; \
            _Pragma("unroll") for (int ks = 0; ks < 4; ++ks) { \
                const s16x4 lo0 = vtr(vb + ks * 16 * VP), hi0 = vtr(vb + (ks * 16 + 8) * VP), lo1 = vtr(vb + ks * 16 * VP + 64), hi1 = vtr(vb + (ks * 16 + 8) * VP + 64); \
                const bf16x8 vf0 = __builtin_shufflevector(lo0, hi0, 0, 1, 2, 3, 4, 5, 6, 7), vf1 = __builtin_shufflevector(lo1, hi1, 0, 1, 2, 3, 4, 5, 6, 7); \
                o0 = AMFMA(pa[ks], vf0, o0); o1 = AMFMA(pa[ks], vf1, o1); \
                _Pragma("unroll") for (int e = 0; e < 4; ++e) { X0[4 * ks + e] = __builtin_amdgcn_exp2f(S0[4 * ks + e]); X1[4 * ks + e] = __builtin_amdgcn_exp2f(S1[4 * ks + e]); } \
            } \
        } \
        if ((t) + 1 < NT) ATT_STOREK(Q, Q); ATT_STOREV(P, P); \
        __syncthreads(); } while (0)
    if (!u.band) {
        const int NT = u.nsub >> 6;
        u32x4 rk00, rk10 = (u32x4){0u, 0u, 0u, 0u}, rv0, rk01, rk11 = (u32x4){0u, 0u, 0u, 0u}, rv1;
        ATT_LOADK(0, 0); ATT_STOREK(0, 0);
        ATT_LOADK(1, 1); ATT_LOADV(0, 0);
        __syncthreads();
        f32x16 X0, X1;
#pragma unroll
        for (int i = 0; i < 16; ++i) { X0[i] = 0.f; X1[i] = 0.f; }
        {
            if (2 < NT) ATT_LOADK(2, 0); ATT_LOADV(1, 1);
            if (wact) {
                const ALAS unsigned char* kb = lds + r * KP + h * 16;
                f32x16 S0 = negm, S1 = negm;
#pragma unroll
                for (int d0 = 0; d0 < NF; ++d0) {
                    const bf16x8 k0 = *(const ALAS bf16x8*)(kb + d0 * 32), k1 = *(const ALAS bf16x8*)(kb + 32 * KP + d0 * 32);
                    S0 = AMFMA(k0, qf[d0], S0); S1 = AMFMA(k1, qf[d0], S1);
                }
#pragma unroll
                for (int i = 0; i < 16; ++i) { X0[i] = __builtin_amdgcn_exp2f(S0[i]); X1[i] = __builtin_amdgcn_exp2f(S1[i]); }
            }
            ATT_STOREK(1, 1); ATT_STOREV(0, 0);
            __syncthreads();
        }
        int t = 1;
        for (; t + 1 < NT; t += 2) { ATT_DENSE_BODY(t, 1, 0); ATT_DENSE_BODY(t + 1, 0, 1); }
        if (t < NT) ATT_DENSE_BODY(t, 1, 0);
        if (wact) {
            const ALAS unsigned char* vb = lds + V_OFF + ((NT - 1) & 1) * VBUF + (4 * h + ((lane & 15) >> 2)) * VP + ((lane >> 4) & 1) * 32 + (lane & 3) * 8;
            bf16x8 pa[4]; float sacc = 0.f, sacc2 = 0.f;
            ATT_SUMPACK4(X0, 0, pa[0]); ATT_SUMPACK4(X0, 8, pa[1]); ATT_SUMPACK4(X1, 0, pa[2]); ATT_SUMPACK4(X1, 8, pa[3]);
            lsum += sacc + sacc2;
#pragma unroll
            for (int ks = 0; ks < 4; ++ks) {
                const s16x4 lo0 = vtr(vb + ks * 16 * VP), hi0 = vtr(vb + (ks * 16 + 8) * VP), lo1 = vtr(vb + ks * 16 * VP + 64), hi1 = vtr(vb + (ks * 16 + 8) * VP + 64);
                const bf16x8 vf0 = __builtin_shufflevector(lo0, hi0, 0, 1, 2, 3, 4, 5, 6, 7), vf1 = __builtin_shufflevector(lo1, hi1, 0, 1, 2, 3, 4, 5, 6, 7);
                o0 = AMFMA(pa[ks], vf0, o0); o1 = AMFMA(pa[ks], vf1, o1);
            }
        }
        __syncthreads();
    } else if constexpr (DQ == 64) {
        constexpr int MAXT = 6, VB_OFF = MAXT * KBUF;
        const int nt = thi - tlo;
        u32x4 rk[MAXT], rv[MAXT];
#pragma unroll
        for (int i = 0; i < MAXT; ++i) if (i < nt) { const size_t ro_ = (size_t)(tlo + i) * 64; rk[i] = *(const u32x4*)(kg0 + ro_ * u.krs); rv[i] = *(const u32x4*)(vg + ro_ * u.vrs); }
#pragma unroll
        for (int i = 0; i < MAXT; ++i) if (i < nt) { *(ALAS u32x4*)(lds + i * KBUF + kl0) = rk[i]; *(ALAS u32x4*)(lds + VB_OFF + i * VBUF + (vl - V_OFF)) = rv[i]; }
        __syncthreads();
        for (int i = 0; i < nt; ++i) {
            const int t = tlo + i, tb = t * 64;
            if (!wact || tb + 63 < qs - u.band || tb > qs + 31 + u.band) continue;
            const ALAS unsigned char* kb = lds + i * KBUF + r * KP + h * 16;
            f32x16 p0 = negm, p1 = negm;
#pragma unroll
            for (int d0 = 0; d0 < NF; ++d0) {
                const bf16x8 k0 = *(const ALAS bf16x8*)(kb + d0 * 32), k1 = *(const ALAS bf16x8*)(kb + 32 * KP + d0 * 32);
                p0 = AMFMA(k0, qf[d0], p0); p1 = AMFMA(k1, qf[d0], p1);
            }
            const int rel_base = tb + 4 * h - (qs + r);
#pragma unroll
            for (int e = 0; e < 16; ++e) {
                const int rel0 = rel_base + (e & 3) + 8 * (e >> 2), rel1 = rel0 + 32;
                const int a0 = rel0 < 0 ? -rel0 : rel0, a1 = rel1 < 0 ? -rel1 : rel1;
                p0[e] = a0 <= u.band ? p0[e] - slope2 * (float)a0 : -INFINITY;
                p1[e] = a1 <= u.band ? p1[e] - slope2 * (float)a1 : -INFINITY;
            }
            float sacc = 0.f, sacc2 = 0.f;
#pragma unroll
            for (int e = 0; e < 16; ++e) { p0[e] = __builtin_amdgcn_exp2f(p0[e]); p1[e] = __builtin_amdgcn_exp2f(p1[e]); }
            bf16x8 pa[4];
            ATT_SUMPACK4(p0, 0, pa[0]); ATT_SUMPACK4(p0, 8, pa[1]); ATT_SUMPACK4(p1, 0, pa[2]); ATT_SUMPACK4(p1, 8, pa[3]);
            lsum += sacc + sacc2;
            const ALAS unsigned char* vb = lds + VB_OFF + i * VBUF + (4 * h + ((lane & 15) >> 2)) * VP + ((lane >> 4) & 1) * 32 + (lane & 3) * 8;
#pragma unroll
            for (int ks = 0; ks < 4; ++ks) {
                const s16x4 lo0 = vtr(vb + ks * 16 * VP), hi0 = vtr(vb + (ks * 16 + 8) * VP), lo1 = vtr(vb + ks * 16 * VP + 64), hi1 = vtr(vb + (ks * 16 + 8) * VP + 64);
                const bf16x8 vf0 = __builtin_shufflevector(lo0, hi0, 0, 1, 2, 3, 4, 5, 6, 7), vf1 = __builtin_shufflevector(lo1, hi1, 0, 1, 2, 3, 4, 5, 6, 7);
                o0 = AMFMA(pa[ks], vf0, o0); o1 = AMFMA(pa[ks], vf1, o1);
            }
        }
        __syncthreads();
    }
#undef ATT_LOADK
#undef ATT_LOADV
#undef ATT_STOREK
#undef ATT_STOREV
#undef ATT_SUMPACK4
#undef ATT_DENSE_BODY
    if (wact) {
        lsum += __shfl_xor(lsum, 32);
        if (u.sink) lsum += exp2f(u.sink[u.hq0 + hl] * LOG2E - mb2);
        const float linv = 1.f / lsum;
        bf16_t* op = u.O + (size_t)hl * u.ohs + r;
#pragma unroll
        for (int i = 0; i < 16; ++i) { const int qi = crow(i, h); const float f = __shfl(linv, qi); bf16_t* orow = op + (size_t)(qs + qi) * u.ors;
            orow[0] = (bf16_t)(cvtpk(o0[i] * f, 0.f) & 0xffffu); orow[32] = (bf16_t)(cvtpk(o1[i] * f, 0.f) & 0xffffu); }
        if (u.lse && h == 0) u.lse[(size_t)(qs + r) * u.lrs] = (mb2 + log2f(lsum)) * LN2;
    }
}

template <int DQ> __device__ __forceinline__ float logit_bound2(const float* gq, const float* gk, int lane) {
    float a = 0.f, b = 0.f;
    for (int i = lane; i < DQ; i += 64) { a = fmaxf(a, fabsf(gq[i])); b = fmaxf(b, fabsf(gk[i])); }
#pragma unroll
    for (int o = 1; o < 64; o <<= 1) { a = fmaxf(a, __shfl_xor(a, o)); b = fmaxf(b, __shfl_xor(b, o)); }
    return a * b * sqrtf((float)DQ) * LOG2E;
}
}

#define LAS __attribute__((address_space(3)))
typedef unsigned short bf16;
typedef unsigned v4u __attribute__((ext_vector_type(4)));
typedef float f32x4 __attribute__((ext_vector_type(4)));
constexpr int M = 32768, DM = 1024, FF = 2816, MP = 16384, SL = 2048;
constexpr size_t MiB = 1u << 20;
constexpr size_t WS_PS = 1 * MiB, WS_PS2 = 3 * MiB, WS_LSE = 5 * MiB, WS_W = 8 * MiB, WS_XB = 56 * MiB, WS_BIG = 120 * MiB, WS_END = 408 * MiB;
constexpr size_t W_UP0 = 0, W_DN0 = 11 * MiB, W_UP1 = 16 * MiB + MiB / 2, W_DN1 = 27 * MiB + MiB / 2, W_MIX = 33 * MiB;
constexpr int LDS_BYTES = 147456;
constexpr int NWAVES = 8;
constexpr float LOG2E = 1.4426950408889634f;

__device__ __forceinline__ unsigned f2bf(float f) { unsigned u = __builtin_bit_cast(unsigned, f); return (u + 0x7fffu + ((u >> 16) & 1u)) >> 16; }
__device__ __forceinline__ unsigned pk2(float lo, float hi) { return f2bf(lo) | (f2bf(hi) << 16); }
__device__ __forceinline__ float bflo(unsigned w) { return __uint_as_float(w << 16); }
__device__ __forceinline__ float bfhi(unsigned w) { return __uint_as_float(w & 0xffff0000u); }
__device__ __forceinline__ void ld8(const bf16* p, float (&v)[8]) { const v4u w = *(const v4u*)p; v[0] = bflo(w.x); v[1] = bfhi(w.x); v[2] = bflo(w.y); v[3] = bfhi(w.y); v[4] = bflo(w.z); v[5] = bfhi(w.z); v[6] = bflo(w.w); v[7] = bfhi(w.w); }
__device__ __forceinline__ void st8(bf16* p, const float (&v)[8]) { v4u w; w.x = pk2(v[0], v[1]); w.y = pk2(v[2], v[3]); w.z = pk2(v[4], v[5]); w.w = pk2(v[6], v[7]); *(v4u*)p = w; }
__device__ __forceinline__ float wave_sum(float v) {
#pragma unroll
    for (int o = 1; o < 64; o <<= 1) v += __shfl_xor(v, o);
    return v;
}

__device__ __forceinline__ void conv_item(const float* W, int K, int N, bf16* WT, int drow0, const float* g, LAS float* scr, int k0, int n0, int lane) {
#pragma unroll 8
    for (int i = 0; i < 32; ++i) { const int kk = 2 * i + (lane >> 5); float v = __builtin_nontemporal_load(W + (size_t)(k0 + kk) * N + n0 + (lane & 31)); if (g) v *= g[k0 + kk]; scr[kk * 33 + (lane & 31)] = v; }
    asm volatile("s_waitcnt lgkmcnt(0)" ::: "memory");
    const int c = lane & 7;
#pragma unroll
    for (int j = 0; j < 4; ++j) { const int n = (lane >> 3) + 8 * j; const LAS float* s = scr + (8 * c) * 33 + n;
        v4u o; o.x = pk2(s[0 * 33], s[1 * 33]); o.y = pk2(s[2 * 33], s[3 * 33]); o.z = pk2(s[4 * 33], s[5 * 33]); o.w = pk2(s[6 * 33], s[7 * 33]);
        *(v4u*)(WT + (size_t)(drow0 + n) * K + k0 + 8 * c) = o; }
    asm volatile("s_waitcnt lgkmcnt(0)" ::: "memory");
}
struct ConvD { const float* W; bf16* WT; const float* g; int K, N, dr, k0, n0; bool valid; };
__device__ __forceinline__ void conv_load(const ConvD& d, f32x4 (&v)[8], float (&gk)[8], int lane) {
    const int kr = lane >> 3, n4 = lane & 7;
#pragma unroll
    for (int i = 0; i < 8; ++i) { const int kk = 8 * i + kr; v[i] = __builtin_nontemporal_load((const f32x4*)(d.W + (size_t)(d.k0 + kk) * d.N + d.n0 + 4 * n4)); gk[i] = d.g ? d.g[d.k0 + kk] : 1.f; }
}
__device__ __forceinline__ void conv_finish(const ConvD& d, const f32x4 (&v)[8], const float (&gk)[8], LAS float* scr, int lane) {
    const int kr = lane >> 3, n4 = lane & 7;
#pragma unroll
    for (int i = 0; i < 8; ++i) { LAS float* p = scr + (8 * i + kr) * 33 + 4 * n4; p[0] = v[i][0] * gk[i]; p[1] = v[i][1] * gk[i]; p[2] = v[i][2] * gk[i]; p[3] = v[i][3] * gk[i]; }
    asm volatile("s_waitcnt lgkmcnt(0)" ::: "memory");
    const int c = lane & 7;
#pragma unroll
    for (int j = 0; j < 4; ++j) { const int n = (lane >> 3) + 8 * j; const LAS float* sp = scr + (8 * c) * 33 + n;
        v4u o; o.x = pk2(sp[0 * 33], sp[1 * 33]); o.y = pk2(sp[2 * 33], sp[3 * 33]); o.z = pk2(sp[4 * 33], sp[5 * 33]); o.w = pk2(sp[6 * 33], sp[7 * 33]);
        *(v4u*)(d.WT + (size_t)(d.dr + n) * d.K + d.k0 + 8 * c) = o; }
    asm volatile("s_waitcnt lgkmcnt(0)" ::: "memory");
}
#define CJD(Wp, K_, N_, WTp, gp, MODE, ROWOFF) if (!d.valid) { const int nblk_ = (N_) / 32, nit_ = ((K_) / 64) * nblk_; if (r < nit_) { const int kb_ = r / nblk_, nb_ = r - kb_ * nblk_, n0_ = 32 * nb_; \
    d.W = (Wp); d.K = (K_); d.N = (N_); d.WT = (WTp); d.g = (gp); d.k0 = 64 * kb_; d.n0 = n0_; d.valid = true; \
    d.dr = (MODE) == 1 ? 256 * (n0_ >> 7) + (n0_ & 127) + (ROWOFF) : ((MODE) == 2 ? 256 * (n0_ >> 8) + 128 * ((n0_ >> 5) & 1) + 32 * ((n0_ >> 6) & 3) + (ROWOFF) : n0_ + (ROWOFF)); } else r -= nit_; }
#define CJ(Wp, K_, N_, WTp, gp, MODE, ROWOFF) { const int nblk_ = (N_) / 32, nit_ = ((K_) / 64) * nblk_; if (r < nit_) { const int kb_ = r / nblk_, nb_ = r - kb_ * nblk_, n0_ = 32 * nb_; \
    const int dr_ = (MODE) == 1 ? 256 * (n0_ >> 7) + (n0_ & 127) + (ROWOFF) : ((MODE) == 2 ? 256 * (n0_ >> 8) + 128 * ((n0_ >> 5) & 1) + 32 * ((n0_ >> 6) & 3) + (ROWOFF) : n0_ + (ROWOFF)); conv_item((Wp), (K_), (N_), (WTp), dr_, (gp), scr, 64 * kb_, n0_, lane); continue; } r -= nit_; }

#define RLX_AGENT __ATOMIC_RELAXED, __HIP_MEMORY_SCOPE_AGENT
#define XB_TMO      128
#define XB_XCNT(j)  (256  + 64 * (j))
#define XB_XSUB(j)  (1280 + 64 * (j))
#define XB_XGEN(j)  (2304 + 64 * (j))
#define XB_TOP      3328
#define XB_TOPGEN   3392
#define XCD_BAR_WORDS 3456
#define XB_SPIN_CAP (1u << 18)

__device__ __forceinline__ unsigned xb_ld(unsigned* p)              { return __hip_atomic_load(p, __ATOMIC_RELAXED, __HIP_MEMORY_SCOPE_AGENT); }
__device__ __forceinline__ unsigned xb_add(unsigned* p, unsigned v) { return __hip_atomic_fetch_add(p, v, __ATOMIC_RELAXED, __HIP_MEMORY_SCOPE_AGENT); }
__device__ __forceinline__ unsigned xb_xcc_id() { return (unsigned)__builtin_amdgcn_s_getreg((3 << 11) | 20) & 0xFu; }
#define XB_SPIN(cond, bar) do { unsigned _sp = 0; while (cond) { __builtin_amdgcn_s_sleep(1); \
    if ((++_sp & 255u) == 0u) { if (xb_ld(&(bar)[XB_TMO])) break; if (_sp > XB_SPIN_CAP) { atomicAdd(&(bar)[XB_TMO], 1u); break; } } } } while (0)

struct XcdBarrier {
    unsigned* bar; unsigned x;
    volatile LAS unsigned* st;
};

__device__ __forceinline__ XcdBarrier xcd_barrier_post(unsigned* bar, volatile LAS unsigned* st) {
    XcdBarrier b; b.bar = bar; b.x = xb_xcc_id(); b.st = st;
    if (threadIdx.x == 0) (void)xb_add(&bar[XB_XCNT(b.x)], 1u);
    return b;
}
__device__ __forceinline__ void xcd_barrier_complete(unsigned* bar, unsigned x, unsigned& nloc, unsigned& nx) {
    const unsigned G = gridDim.x * gridDim.y * gridDim.z;
    unsigned sum, cnt, mine, sp = 0u;
    for (;;) {
        sum = 0u; cnt = 0u; mine = 0u;
#pragma unroll
        for (unsigned j = 0; j < 16; ++j) { const unsigned c = xb_ld(&bar[XB_XCNT(j)]); sum += c; cnt += (c > 0u) ? 1u : 0u; mine = (j == x) ? c : mine; }
        if (sum == G) break;
        __builtin_amdgcn_s_sleep(1);
        if ((++sp & 255u) == 0u) { if (xb_ld(&bar[XB_TMO])) break; if (sp > XB_SPIN_CAP) { atomicAdd(&bar[XB_TMO], 1u); break; } }
    }
    nloc = mine > 0u ? mine : 1u; nx = cnt > 0u ? cnt : 1u;
}

__device__ __forceinline__ void xcd_barrier(const XcdBarrier& b) {
    asm volatile("s_waitcnt vmcnt(0)" ::: "memory");
    __syncthreads();
    if (threadIdx.x == 0) {
        unsigned* bar = b.bar;
        __builtin_amdgcn_s_waitcnt(0);
        unsigned nloc = b.st[0], nx = b.st[1];
        if (nloc == 0u) { xcd_barrier_complete(bar, b.x, nloc, nx); b.st[0] = nloc; b.st[1] = nx; }
        const unsigned old = xb_add(&bar[XB_XSUB(b.x)], 1u);
        const unsigned gen = old / nloc;
        if (old + 1u == (gen + 1u) * nloc) {
            __builtin_amdgcn_fence(__ATOMIC_RELEASE, "agent");
            asm volatile("s_waitcnt vmcnt(0)" ::: "memory");
            const unsigned og = xb_add(&bar[XB_TOP], 1u);
            const unsigned tg = og / nx;
            if (og + 1u == (tg + 1u) * nx) xb_add(&bar[XB_TOPGEN], 1u);
            else XB_SPIN(xb_ld(&bar[XB_TOPGEN]) == tg, bar);
            __builtin_amdgcn_fence(__ATOMIC_ACQUIRE, "agent");
            xb_add(&bar[XB_XGEN(b.x)], 1u);
            asm volatile("s_waitcnt vmcnt(0)" ::: "memory");
        } else {
            XB_SPIN(xb_ld(&bar[XB_XGEN(b.x)]) == gen, bar);
            __builtin_amdgcn_fence(__ATOMIC_ACQUIRE, "agent");
            asm volatile("s_waitcnt vmcnt(0)" ::: "memory");
        }
    }
    __syncthreads();
}

struct Args { const float* in[33]; float* out; unsigned char* ws; };

__device__ __forceinline__ void conv_phase(const Args& a, int L, LAS unsigned char* lds, int gw, int NGW, int lane, int wave) {
    LAS float* scr = (LAS float*)(lds + wave * 16384);
    bf16* Wb = (bf16*)(a.ws + WS_W);
    const size_t so = (size_t)L * DM * FF;
    const float* g1 = a.in[2] + L * DM; const float* gm = a.in[6] + L * DM; const float* g2 = a.in[7] + L * DM;
    bf16* up0 = Wb + W_UP0 / 2; bf16* dn0 = Wb + W_DN0 / 2; bf16* up1 = Wb + W_UP1 / 2; bf16* dn1 = Wb + W_DN1 / 2; bf16* mix = Wb + W_MIX / 2;
#define CONV_DECODE(dd, item) do { ConvD d; d.valid = false; d.W = nullptr; d.WT = nullptr; d.g = nullptr; d.K = 0; d.N = 0; d.dr = 0; d.k0 = 0; d.n0 = 0; int r = (item); \
        if (r < 16384) { \
        CJD(a.in[3] + so, DM, FF, up0, g1, 1, 0) \
        CJD(a.in[4] + so, DM, FF, up0, g1, 1, 128) \
        CJD(a.in[5] + so, FF, DM, dn0, (const float*)nullptr, 0, 0) \
        CJD(a.in[8] + so, DM, FF, up1, g2, 1, 0) \
        CJD(a.in[9] + so, DM, FF, up1, g2, 1, 128) \
        CJD(a.in[10] + so, FF, DM, dn1, (const float*)nullptr, 0, 0) \
        if (L == 0) { \
            CJD(a.in[11], DM, 1536, mix, gm, 2, 0) \
            CJD(a.in[15], DM, DM, mix + 3 * MiB / 2, (const float*)nullptr, 0, 0) \
        } else if (L == 1) { \
            CJD(a.in[16], DM, 512, mix, gm, 0, 0) \
            CJD(a.in[19], DM, 288, mix, gm, 0, 512) \
            CJD(a.in[18], 512, 1536, mix + 2 * MiB / 2, a.in[17], 0, 0) \
            CJD(a.in[21], 256, 2048, mix + (3 * MiB + MiB / 2) / 2, a.in[20], 0, 0) \
            CJD(a.in[24], DM, DM, mix + (4 * MiB + MiB / 2) / 2, (const float*)nullptr, 0, 0) \
        } else if (L == 2) { \
            CJD(a.in[25], DM, 4608, mix, gm, 2, 0) \
            CJD(a.in[28], 512, DM, mix + 9 * MiB / 2, (const float*)nullptr, 0, 0) \
        } else { \
            CJD(a.in[29], DM, 1536, mix, gm, 0, 0) \
            CJD(a.in[32], DM, DM, mix + 3 * MiB / 2, (const float*)nullptr, 0, 0) \
        } } \
        dd = d; } while (0)
    {
        f32x4 va[8], vb[8]; float ga[8], gb[8]; ConvD d0, d1;
        int it = gw;
        CONV_DECODE(d0, it);
        if (d0.valid) {
            conv_load(d0, va, ga, lane);
            for (;;) {
                CONV_DECODE(d1, it + NGW); if (d1.valid) conv_load(d1, vb, gb, lane);
                conv_finish(d0, va, ga, scr, lane);
                if (!d1.valid) break;
                it += 2 * NGW;
                CONV_DECODE(d0, it); if (d0.valid) conv_load(d0, va, ga, lane);
                conv_finish(d1, vb, gb, scr, lane);
                if (!d0.valid) break;
            }
        }
    }
#undef CONV_DECODE
    if (L == 1) {
        v4u* z = (v4u*)(mix + (size_t)800 * 1024);
        for (int i = gw * 64 + lane; i < 224 * 1024 / 8; i += NGW * 64) z[i] = (v4u){0u, 0u, 0u, 0u};
    }
    if (L == 0) {
        bf16* XB = (bf16*)(a.ws + WS_XB); float* PS = (float*)(a.ws + WS_PS);
        for (int row = gw; row < M; row += NGW) {
            const float* src = row < MP ? a.in[0] + (size_t)row * DM : a.in[1] + (size_t)(row - MP) * DM;
            const f32x4* xr = (const f32x4*)src + lane; unsigned long long* xb = (unsigned long long*)(XB + (size_t)row * DM) + lane;
            float ss = 0.f;
#pragma unroll
            for (int j = 0; j < 4; ++j) { const f32x4 v = __builtin_nontemporal_load(xr + 64 * j); ss += (v[0] * v[0] + v[1] * v[1]) + (v[2] * v[2] + v[3] * v[3]);
                xb[64 * j] = (unsigned long long)pk2(v[0], v[1]) | ((unsigned long long)pk2(v[2], v[3]) << 32); }
            ss = wave_sum(ss);
            if (lane < 16) PS[(size_t)row * 16 + lane] = lane == 0 ? ss : 0.f;
        }
    }
}

__device__ __forceinline__ int seq_pos(int row) { return row < MP ? row : ((row - MP) & (SL - 1)); }

__device__ __forceinline__ void prep64(bf16* buf, int kind, const float* gq, const float* gk, int gw, int NGW, int lane) {
    const int pitch = kind == 2 ? 4608 : 1536, nvec = kind == 2 ? 48 : 20, c = lane & 7, grp = lane >> 3;
    float gqv[8], gkv[8], inv[8];
#pragma unroll
    for (int e = 0; e < 8; ++e) { gqv[e] = gq[8 * c + e] * (0.125f * LOG2E); gkv[e] = gk[8 * c + e]; inv[e] = powf(10000.f, -(float)(8 * (c & 1) + e) * (1.f / 16.f)); }
    for (int tb = gw; tb < M / 8; tb += NGW) {
        const int row = tb * 8 + grp;
        bf16* rp = buf + (size_t)row * pitch + 8 * c;
        float cs[8], sn[8];
        if (kind == 3) { const int t = seq_pos(row); const float pos = (float)((c & 4) ? (t & 63) : (t >> 6));
#pragma unroll
            for (int e = 0; e < 8; ++e) { const float ang = pos * inv[e]; cs[e] = cosf(ang); sn[e] = sinf(ang); } }
        for (int v0 = 0; v0 < nvec; v0 += 4) {
            float v[4][8];
#pragma unroll
            for (int j = 0; j < 4; ++j) { const int vi = v0 + j; ld8(rp + (kind == 2 ? 1536 * (vi >> 4) + 64 * (vi & 15) : 64 * vi), v[j]); }
#pragma unroll
            for (int j = 0; j < 4; ++j) {
                const int vi = v0 + j; const bool isq = kind == 2 ? ((vi & 15) < 8) : (vi < 16);
                float ss = 0.f;
#pragma unroll
                for (int e = 0; e < 8; ++e) ss += v[j][e] * v[j][e];
                ss += __shfl_xor(ss, 1); ss += __shfl_xor(ss, 2); ss += __shfl_xor(ss, 4);
                const float rs = rsqrtf(ss * (1.f / 64.f) + 1e-6f);
#pragma unroll
                for (int e = 0; e < 8; ++e) v[j][e] = v[j][e] * rs;
                if (kind == 3) {
#pragma unroll
                    for (int e = 0; e < 8; ++e) { const float mine = v[j][e] * (isq ? gqv[e] : gkv[e]); const float other = __shfl_xor(mine, 2); v[j][e] = (c & 2) ? other * sn[e] + mine * cs[e] : mine * cs[e] - other * sn[e]; }
                } else {
#pragma unroll
                    for (int e = 0; e < 8; ++e) v[j][e] *= (isq ? gqv[e] : gkv[e]);
                }
            }
#pragma unroll
            for (int j = 0; j < 4; ++j) { const int vi = v0 + j; st8(rp + (kind == 2 ? 1536 * (vi >> 4) + 64 * (vi & 15) : 64 * vi), v[j]); }
        }
    }
}

__device__ __forceinline__ void prep_mla(bf16* Qraw, bf16* Kb, const bf16* CQ, const float* gq, const float* gk, int gw, int NGW, int lane) {
    const int c = lane & 15, grp = lane >> 4; const bool live = c < 12, rot = c >= 8 && c < 12;
    float gqv[8], gkv[8], inv[8];
#pragma unroll
    for (int e = 0; e < 8; ++e) { gqv[e] = live ? gq[8 * c + e] * (0.10206207261596575f * LOG2E) : 0.f; gkv[e] = live ? gk[8 * c + e] : 0.f; inv[e] = powf(10000.f, -(float)(8 * (c & 1) + e) * (1.f / 16.f)); }
    for (int tb = gw; tb < M / 4; tb += NGW) {
        const int row = tb * 4 + grp;
        const float pos = (float)seq_pos(row);
        float cs[8], sn[8];
#pragma unroll
        for (int e = 0; e < 8; ++e) { const float ang = pos * inv[e]; cs[e] = cosf(ang); sn[e] = sinf(ang); }
        float kr[8];
#pragma unroll
        for (int e = 0; e < 8; ++e) kr[e] = 0.f;
        if (rot) ld8(CQ + (size_t)row * 1024 + 768 + 8 * (c - 8), kr);
        bf16* qrow = Qraw + (size_t)row * 1536 + 8 * c; bf16* krow = Kb + (size_t)row * 1536 + 8 * c;
        for (int h0 = 0; h0 < 16; h0 += 2) {
            float v[4][8];
#pragma unroll
            for (int j = 0; j < 4; ++j) {
                const int hh = h0 + (j >> 1); const bool isk = j & 1;
#pragma unroll
                for (int e = 0; e < 8; ++e) v[j][e] = 0.f;
                if (isk) { if (c < 8) ld8(krow + hh * 96, v[j]); else {
#pragma unroll
                        for (int e = 0; e < 8; ++e) v[j][e] = kr[e]; } }
                else if (live) ld8(qrow + hh * 96, v[j]);
            }
#pragma unroll
            for (int j = 0; j < 4; ++j) {
                const bool isk = j & 1;
                float ss = 0.f;
#pragma unroll
                for (int e = 0; e < 8; ++e) ss += v[j][e] * v[j][e];
                ss += __shfl_xor(ss, 1); ss += __shfl_xor(ss, 2); ss += __shfl_xor(ss, 4); ss += __shfl_xor(ss, 8);
                const float rs = rsqrtf(ss * (1.f / 96.f) + 1e-6f);
#pragma unroll
                for (int e = 0; e < 8; ++e) { const float mine = v[j][e] * rs * (isk ? gkv[e] : gqv[e]); const float other = __shfl_xor(mine, 2);
                    v[j][e] = rot ? ((c & 2) ? other * sn[e] + mine * cs[e] : mine * cs[e] - other * sn[e]) : mine; }
            }
#pragma unroll
            for (int j = 0; j < 4; ++j) { const int hh = h0 + (j >> 1); if (live) st8(((j & 1) ? krow : qrow) + hh * 96, v[j]); }
        }
    }
}

__device__ __forceinline__ void merge_c(bf16* buf, const float* LSE, int gw, int NGW, int lane) {
    const int hh = lane >> 3, c = lane & 7;
    for (int row = gw; row < M; row += NGW) {
        const float l0 = LSE[((size_t)0 * M + row) * 8 + hh], l1 = LSE[((size_t)1 * M + row) * 8 + hh], l2 = LSE[((size_t)2 * M + row) * 8 + hh];
        const float mx = fmaxf(l0, fmaxf(l1, l2)); const float e0 = __expf(l0 - mx), e1 = __expf(l1 - mx), e2 = __expf(l2 - mx); const float inv = 1.f / (e0 + e1 + e2);
        bf16* rp = buf + (size_t)row * 4608 + hh * 64 + 8 * c;
        float a[8], b[8], d[8], o[8]; ld8(rp, a); ld8(rp + 1536, b); ld8(rp + 3072, d);
#pragma unroll
        for (int e = 0; e < 8; ++e) o[e] = (a[e] * e0 + b[e] * e1 + d[e] * e2) * inv;
        st8(rp + 512, o);
    }
}

struct DecAD {
    bf16* buf; const float* sink; int band; bf16* obase; int opitch; int r2;
    __device__ __forceinline__ att::AU operator()(int list, int ui) const {
        int kvh, blk, base, nsub;
        if (list == 0) { kvh = ui >> 8; blk = ui & 255; base = 0; nsub = MP; } else { const int b = ui >> 7; kvh = (ui >> 5) & 3; blk = ui & 31; base = MP + b * SL; nsub = SL; }
        att::AU u; bf16* q = buf + (size_t)base * 1536 + kvh * 256;
        u.Q = q; u.O = obase ? obase + (size_t)base * opitch + kvh * 256 : q; u.K = buf + (size_t)base * 1536 + 1024 + kvh * 64; u.V = buf + (size_t)base * 1536 + 1280 + kvh * 64; u.lse = nullptr; u.sink = sink;
        u.qrs = u.krs = u.vrs = 1536; u.ors = obase ? opitch : 1536; u.lrs = 0; u.q0 = blk * 64; u.nsub = nsub; u.wph = 2; u.qhs = u.ohs = 64; u.band = band; u.hq0 = kvh * 4; u.sl_scale = att::LOG2E; u.sl_exp = 0.5f; u.r2 = r2;
        if (r2) { if (list == 0) { kvh = ui >> 7; blk = ui & 127; } else { const int b = ui >> 6; kvh = (ui >> 4) & 3; blk = ui & 15; base = MP + b * SL; }
            bf16* q2 = buf + (size_t)base * 1536 + kvh * 256; u.Q = q2; u.O = obase ? obase + (size_t)base * opitch + kvh * 256 : q2; u.K = buf + (size_t)base * 1536 + 1024 + kvh * 64; u.V = buf + (size_t)base * 1536 + 1280 + kvh * 64; u.q0 = blk * 128; u.hq0 = kvh * 4; }
        return u;
    }
};
struct DecB {
    const bf16* Q; const bf16* K; const bf16* V; bf16* O;
    __device__ __forceinline__ att::AU operator()(int list, int ui) const {
        int hh, blk, base, nsub;
        if (list == 0) { hh = ui >> 6; blk = ui & 63; base = 0; nsub = MP; } else { const int b = ui >> 7; hh = (ui >> 3) & 15; blk = ui & 7; base = MP + b * SL; nsub = SL; }
        att::AU u; u.Q = Q + (size_t)base * 1536 + hh * 96; u.K = K + (size_t)base * 1536 + hh * 96; u.V = V + (size_t)base * 1024 + hh * 64; u.O = O + (size_t)base * 1024 + hh * 64; u.lse = nullptr; u.sink = nullptr;
        u.qrs = u.krs = 1536; u.vrs = u.ors = 1024; u.lrs = 0; u.q0 = blk * 256; u.nsub = nsub; u.wph = 8; u.qhs = u.ohs = 0; u.band = 0; u.hq0 = hh; u.sl_scale = 0.f; u.sl_exp = 0.f; u.r2 = 1;
        { int hh2, blk2, base2; if (list == 0) { hh2 = ui >> 5; blk2 = ui & 31; base2 = 0; } else { const int b2 = ui >> 6; hh2 = (ui >> 2) & 15; blk2 = ui & 3; base2 = MP + b2 * SL; }
          u.Q = Q + (size_t)base2 * 1536 + hh2 * 96; u.K = K + (size_t)base2 * 1536 + hh2 * 96; u.V = V + (size_t)base2 * 1024 + hh2 * 64; u.O = O + (size_t)base2 * 1024 + hh2 * 64; u.q0 = blk2 * 512; u.hq0 = hh2; }
        return u;
    }
};
struct DecC {
    bf16* buf; float* LSE;
    __device__ __forceinline__ att::AU operator()(int list, int ui) const {
        int g, hh, blk, rr, base, len;
        if (list == 0) { g = ui >> 9; const int w = ui & 511, nbs = 6 - 2 * g; blk = w & ((1 << nbs) - 1); hh = (w >> nbs) & 7; rr = w >> (nbs + 3); base = 0; len = MP; }
        else { const int sq = ui >> 8; int w = ui & 255; base = MP + sq * SL; len = SL;
            if (w < 64) { g = 0; hh = w >> 3; blk = w & 7; rr = 0; } else if (w < 128) { w -= 64; g = 1; blk = w & 1; hh = (w >> 1) & 7; rr = w >> 4; } else { w -= 128; g = 2; blk = 0; hh = w & 7; rr = w >> 3; } }
        const int dil = 1 << (2 * g), t0 = base + rr;
        att::AU u; bf16* q = buf + (size_t)t0 * 4608 + g * 1536 + hh * 64;
        u.Q = q; u.O = q; u.K = q + 512; u.V = q + 1024; u.lse = LSE + ((size_t)g * M + t0) * 8 + hh; u.sink = nullptr;
        u.qrs = u.krs = u.vrs = u.ors = (long)dil * 4608; u.lrs = 8 * dil; u.q0 = blk * 256; u.nsub = len >> (2 * g); u.wph = 8; u.qhs = u.ohs = 0; u.band = 64; u.hq0 = hh; u.sl_scale = att::LOG2E * (float)dil; u.sl_exp = 1.0f; u.r2 = 0;
        return u;
    }
};
template <int DQ, class Dec> __device__ __forceinline__ void attn_phase(LAS unsigned char* lds, int G, int vcu, int n0, int n1, const Dec& dec, float mb2) {
    for (int list = 0; list < 2; ++list) {
        const int n = list ? n1 : n0, per = (n + G - 1) / G;
        for (int i = 0; i < per; ++i) { const int ui = vcu * per + i; if (ui < n) { const att::AU u = dec(list, ui); att::attn_unit<DQ>(u, lds, mb2); } }
    }
}

enum Kind { K_NOP = 0, K_CONV, K_SWIGLU, K_RES, K_BF16, K_PREP, K_ATTN, K_MERGE };

__global__ void __launch_bounds__(NWAVES * 64, 2) fwd_megakernel(Args a) {
    extern __shared__ __attribute__((aligned(16))) unsigned char lds_raw[];
    LAS unsigned char* lds = (LAS unsigned char*)lds_raw;
    cg::grid_group grid = cg::this_grid();
    for (int u_ = threadIdx.x; u_ < (LDS_BYTES - 131072) / 4; u_ += NWAVES * 64) ((LAS unsigned*)(lds + 131072))[u_] = 0u;
    __syncthreads();
    const XcdBarrier xbar = xcd_barrier_post((unsigned*)a.ws, (volatile LAS unsigned*)(lds + 131072 + 320) + 8);
    const int G = gridDim.x, bx = blockIdx.x, vcu = (G % 8 == 0) ? (bx % 8) * (G / 8) + bx / 8 : bx;
    const int NGW = G * NWAVES;
    unsigned char* ws = a.ws;
    float* PS = (float*)(ws + WS_PS); float* PS2 = (float*)(ws + WS_PS2); float* LSE = (float*)(ws + WS_LSE);
    bf16* Wb = (bf16*)(ws + WS_W); bf16* XB = (bf16*)(ws + WS_XB); bf16* BIG = (bf16*)(ws + WS_BIG);
    bf16* mix = Wb + W_MIX / 2;
    bf16* QRAW = BIG + 32 * MiB;
    bf16* KB = BIG + 80 * MiB;

#ifdef PROBE_UP2
    constexpr int SPL = 14, S_UP0 = 1, S_UP0B = 2, S_DN0 = 3, S_MIX0 = 4, S_UP1 = 11, S_UP1B = 12, S_DN1 = 13;
#else
    constexpr int SPL = 12, S_UP0 = 1, S_UP0B = -1, S_DN0 = 2, S_MIX0 = 3, S_UP1 = 10, S_UP1B = -1, S_DN1 = 11;
#endif
    for (int step = 0; step < 4 * SPL; ++step) {
        int tid_o = threadIdx.x; asm volatile("" : "+v"(tid_o));
        const int lane = tid_o & 63, wave = __builtin_amdgcn_readfirstlane(tid_o >> 6), gw = vcu * NWAVES + wave;
        const int L = step / SPL, s = step - L * SPL;
        int kind = K_NOP; bool nosync = false;
        pg8::Gemm g; g.A = nullptr; g.Bt = nullptr; g.M = M; g.N = 0; g.K = 0; g.lda = 0;
        float alpha = 1.f;
        pg8::EpiBf16 eb; eb.O = BIG; eb.O2 = XB; eb.ldc = 0; eb.ps_in = PS; eb.off4 = 0; eb.n4 = 4; eb.inv_dim = 1.f / 1024.f; eb.ps_out = PS2; eb.mode = 0; eb.gq = nullptr; eb.gk = nullptr; eb.nq = 0; eb.nke = 0;
        if (s == 0) kind = K_CONV;
        else if (s == S_UP0 || s == S_UP0B || s == S_UP1 || s == S_UP1B) { kind = K_SWIGLU; g.A = XB; g.lda = DM; g.Bt = Wb + (s < S_MIX0 ? W_UP0 : W_UP1) / 2; g.N = 2 * FF; g.K = DM; }
        else if (s == S_DN0 || s == S_DN1) { kind = K_RES; g.A = BIG; g.lda = FF; g.Bt = Wb + (s == S_DN0 ? W_DN0 : W_DN1) / 2; g.N = DM; g.K = FF; alpha = 0.5f; }
        else {
            int k = s - S_MIX0;
#ifdef PROBE_ATTN2
            if (L == 1 && k >= 5) k -= 1;
            if (L == 3 && k >= 3) k -= 1;
#else
            if (k == 6) k = 7;
#endif
            if (L == 0 || L == 3) {
                if (k == 0) { kind = K_BF16; g.A = XB; g.lda = DM; g.Bt = mix; g.N = 1536; g.K = DM; eb.ldc = 1536; if (L == 0) { eb.mode = 3; eb.gq = a.in[12]; eb.gk = a.in[13]; eb.nq = 4; eb.nke = 5; } }
                else if (k == 1) { if (L == 3) kind = K_PREP; }
                else if (k == 2) kind = K_ATTN;
                else if (k == 3) { kind = K_RES; g.A = L == 0 ? BIG : BIG + 48 * MiB; g.lda = L == 0 ? 1536 : 1024; g.Bt = mix + 3 * MiB / 2; g.N = DM; g.K = DM; }
            } else if (L == 1) {
                if (k == 0) { kind = K_BF16; g.A = XB; g.lda = DM; g.Bt = mix; g.N = 1024; g.K = DM; eb.ldc = 1024; eb.mode = 1; }
                else if (k == 1) { kind = K_BF16; nosync = true; g.A = BIG; g.lda = 1024; g.Bt = mix + 2 * MiB / 2; g.N = 1536; g.K = 512; eb.O = QRAW; eb.ldc = 1536; eb.ps_in = PS2; eb.off4 = 0; eb.n4 = 2; eb.inv_dim = 1.f / 512.f; }
                else if (k == 2) { kind = K_BF16; g.A = BIG + 512; g.lda = 1024; g.Bt = mix + (3 * MiB + MiB / 2) / 2; g.N = 2048; g.K = 256; eb.O = KB; eb.O2 = (bf16*)a.out; eb.ldc = 1536; eb.ps_in = PS2; eb.off4 = 2; eb.n4 = 1; eb.inv_dim = 1.f / 256.f; eb.mode = 2; }
                else if (k == 3) kind = K_PREP;
                else if (k == 4) kind = K_ATTN;
                else if (k == 5) { kind = K_RES; g.A = BIG; g.lda = 1024; g.Bt = mix + (4 * MiB + MiB / 2) / 2; g.N = DM; g.K = DM; }
            } else {
                if (k == 0) { kind = K_BF16; g.A = XB; g.lda = DM; g.Bt = mix; g.N = 4608; g.K = DM; eb.ldc = 4608; eb.mode = 3; eb.gq = a.in[26]; eb.gk = a.in[27]; eb.nq = 2; eb.nke = 4; }
                else if (k == 1) { }
                else if (k == 2) kind = K_ATTN;
                else if (k == 3) kind = K_MERGE;
                else if (k == 4) { kind = K_RES; g.A = BIG + 512; g.lda = 4608; g.Bt = mix + 9 * MiB / 2; g.N = DM; g.K = 512; }
            }
        }
        if (kind == K_NOP) continue;
        if (kind == K_CONV) conv_phase(a, L, lds, gw, NGW, lane, wave);
        else if (kind == K_SWIGLU) { pg8::StaticOrder S; S.init(M, g.N, G, bx); pg8::EpiSwiglu E{BIG, PS}; pg8::gemm_phase<pg8::EpiSwiglu, pg8::StaticOrder, true, true>(lds, g, S, E); }
        else if (kind == K_RES) { pg8::StaticOrder S; S.init(M, g.N, G, bx); pg8::EpiRes E{step == 4 * SPL - 1 ? a.out : (float*)nullptr, XB, PS, alpha}; pg8::gemm_phase<pg8::EpiRes, pg8::StaticOrder, true, true>(lds, g, S, E); }
        else if (kind == K_BF16) { pg8::StaticOrder S; S.init(M, g.N, G, bx); pg8::gemm_phase<pg8::EpiBf16, pg8::StaticOrder, true, true>(lds, g, S, eb); }
        else if (kind == K_PREP) {
            if (L == 0) prep64(BIG, 0, a.in[12], a.in[13], gw, NGW, lane);
            else if (L == 1) prep_mla(QRAW, KB, BIG, a.in[22], a.in[23], gw, NGW, lane);
            else if (L == 2) prep64(BIG, 2, a.in[26], a.in[27], gw, NGW, lane);
            else prep64(BIG, 3, a.in[30], a.in[31], gw, NGW, lane);
        }
        else if (kind == K_ATTN) {
            if (L == 1) { const float mb2 = att::logit_bound2<96>(a.in[22], a.in[23], lane); DecB d{QRAW, KB, (const bf16*)a.out, BIG}; attn_phase<96, DecB>(lds, G, vcu, 512, 512, d, mb2); }
            else if (L == 2) { const float mb2 = att::logit_bound2<64>(a.in[26], a.in[27], lane); DecC d{BIG, LSE}; attn_phase<64, DecC>(lds, G, vcu, 1536, 2048, d, mb2); }
            else { const float mb2 = att::logit_bound2<64>(L == 0 ? a.in[12] : a.in[30], L == 0 ? a.in[13] : a.in[31], lane);
                   DecAD d{BIG, L == 0 ? a.in[14] : (const float*)nullptr, L == 0 ? 128 : 0, L == 0 ? (bf16*)nullptr : BIG + 48 * MiB, 1024, L == 0 ? 0 : 1}; attn_phase<64, DecAD>(lds, G, vcu, L == 0 ? 1024 : 512, L == 0 ? 1024 : 512, d, mb2); }
        }
        else if (kind == K_MERGE) merge_c(BIG, LSE, gw, NGW, lane);
        if (nosync || step == 4 * SPL - 1) continue;
        if (step == 0) grid.sync();
        else xcd_barrier(xbar);
    }
}

extern "C" void kernel_launch(void* const* d_in, const int* in_sizes, int n_in, void* d_out, int out_size, void* d_ws, size_t ws_size, hipStream_t stream) {
    static int grid = 0;
    if (grid == 0) {
        if (n_in != 33 || out_size != M * DM || ws_size < WS_END) { fprintf(stderr, "kernel_launch: unexpected shapes (n_in %d, out %d, ws %zu)\n", n_in, out_size, ws_size); grid = -1; return; }
        int dev = 0, cus = 0, per_cu = 0;
        hipGetDevice(&dev); hipDeviceGetAttribute(&cus, hipDeviceAttributeMultiprocessorCount, dev);
        hipFuncSetAttribute((const void*)fwd_megakernel, hipFuncAttributeMaxDynamicSharedMemorySize, LDS_BYTES);
        hipOccupancyMaxActiveBlocksPerMultiprocessor(&per_cu, (const void*)fwd_megakernel, NWAVES * 64, LDS_BYTES);
        if (per_cu < 1) per_cu = 1;
        (void)hipGetLastError();
        grid = cus * per_cu;
    }
    if (grid < 0) return;
    if (hipMemsetAsync(d_ws, 0, 65536, stream) != hipSuccess) { fprintf(stderr, "kernel_launch: memset of barrier words failed\n"); return; }
    Args a{};
    for (int i = 0; i < 33; ++i) a.in[i] = (const float*)d_in[i];
    a.out = (float*)d_out; a.ws = (unsigned char*)d_ws;
    void* kargs[] = {&a};
    hipError_t e = hipLaunchCooperativeKernel((const void*)fwd_megakernel, dim3(grid), dim3(NWAVES * 64), kargs, LDS_BYTES, stream);
    if (e != hipSuccess) fprintf(stderr, "cooperative launch failed: %s (grid %d)\n", hipGetErrorString(e), grid);
}
```

```cpp
#include <hip/hip_runtime.h>
#include <hip/hip_cooperative_groups.h>
#include <cstdio>
#include <cstdint>
namespace cg = cooperative_groups;
namespace pg8 {
#define PG8_LAS __attribute__((address_space(3)))
typedef unsigned short bf16_t;
typedef short bf16x8 __attribute__((ext_vector_type(8)));
typedef float f32x4 __attribute__((ext_vector_type(4)));
typedef unsigned u32x4 __attribute__((ext_vector_type(4)));
constexpr int BM = 256, BK = 64, HALF = 128, HTB = HALF * BK * 2  , STAGE_BYTES = 8 * HTB, NXCD = 8, WGM = 8;

__host__ __device__ __forceinline__ int lds_byte(int r, int c) { const int st = (r >> 4) * 2 + (c >> 5), rr = r & 15, cc = c & 31, ob = rr * 64 + cc * 2; return st * 1024 + (ob ^ (((ob >> 9) & 1) << 5)); }
__host__ __device__ __forceinline__ void stage_rc(int b, int& R, int& C) { const int st = b / 1024, sb = b % 1024, swz = sb ^ (((sb >> 9) & 1) << 5); R = (st >> 1) * 16 + swz / 64; C = (st & 1) * 32 + (swz % 64) / 2; }
__host__ __device__ __forceinline__ int perm32(int rho) { const int n = rho >> 4, i = rho & 15; return 8 * (i >> 2) + 4 * n + (i & 3); }

struct Unit { int pm, pn; };
struct Gemm { const bf16_t* A; const bf16_t* Bt; int M, N, K, lda; };

struct StaticOrder {
    int nM, nN, nwg, G, c;
    __host__ __device__ void init(int M, int N, int G_, int c_) { nM = M / BM; nN = N / BM; nwg = nM * nN; G = G_; c = c_; }
    __host__ __device__ bool next(int i, Unit& u) const {
        const long L = (long)i * G + c; if (L >= nwg) return false;
        int wgid = (int)L; { const int q = nwg / NXCD, r = nwg % NXCD, xcd = wgid % NXCD, off = wgid / NXCD; wgid = (xcd < r ? xcd * (q + 1) : r * (q + 1) + (xcd - r) * q) + off; }
        const int nig = WGM * nN, gid = wgid / nig, fm = gid * WGM, gsz = (nM - fm) < WGM ? (nM - fm) : WGM;
        u.pm = fm + ((wgid % nig) % gsz); u.pn = (wgid % nig) / gsz; return true;
    }
    __device__ __forceinline__ void a_ready(const Unit&) const {}
    __device__ __forceinline__ void done(const Unit&) const {}
};

__device__ __forceinline__ unsigned cvt_pk_bf16(float lo, float hi) { unsigned r; asm volatile("v_cvt_pk_bf16_f32 %0, %1, %2" : "=v"(r) : "v"(lo), "v"(hi)); return r; }
typedef float f32x2 __attribute__((ext_vector_type(2)));
__device__ __forceinline__ float rstd_from(const float* ps, int row, int off4, int n4, float inv_dim, int fq) {
    float s = 0.f;
    if (fq < n4) { const f32x4 v = *((const f32x4*)(ps + (size_t)row * 16) + off4 + fq); s = (v[0] + v[1]) + (v[2] + v[3]); }
    s += __shfl_xor(s, 16); s += __shfl_xor(s, 32);
    return rsqrtf(s * inv_dim + 1e-6f);
}
struct EpiSwiglu {
    static constexpr bool PERM = true, AFTER_DRAIN = false;
    bf16_t* H; const float* ps;
    __device__ __forceinline__ void operator()(const f32x4 (&acc)[2][2][4][2], const Unit& u, int wr, int wc, int fr, int fq) const {
        const int row0 = u.pm * BM + wr * 64 + fr, col0 = u.pn * 128 + wc * 32 + 8 * fq;
#pragma unroll
        for (int ai = 0; ai < 2; ++ai)
#pragma unroll
            for (int m = 0; m < 4; ++m) {
                const int row = row0 + ai * HALF + m * 16;
                const float rs = rstd_from(ps, row, 0, 4, 1.f / 1024.f, fq);
                float hv[8];
#pragma unroll
                for (int n = 0; n < 2; ++n)
#pragma unroll
                    for (int e = 0; e < 4; ++e) { const float gt = acc[ai][0][m][n][e] * rs, up = acc[ai][1][m][n][e] * rs;
                        hv[n * 4 + e] = gt * __builtin_amdgcn_rcpf(1.f + __builtin_amdgcn_exp2f(-1.4426950408889634f * gt)) * up; }
                u32x4 w; w.x = cvt_pk_bf16(hv[0], hv[1]); w.y = cvt_pk_bf16(hv[2], hv[3]); w.z = cvt_pk_bf16(hv[4], hv[5]); w.w = cvt_pk_bf16(hv[6], hv[7]);
                *(u32x4*)(H + (size_t)row * 2816 + col0) = w;
            }
    }
};
struct EpiRes {
    static constexpr bool PERM = true, AFTER_DRAIN = false;
    float* OUT; bf16_t* XB; float* ps; float alpha;
    __device__ __forceinline__ void operator()(const f32x4 (&acc)[2][2][4][2], const Unit& u, int wr, int wc, int fr, int fq) const {
        const int row0 = u.pm * BM + wr * 64 + fr, col0 = u.pn * BM + wc * 32 + 8 * fq;
#pragma unroll
        for (int ai = 0; ai < 2; ++ai)
#pragma unroll
            for (int m = 0; m < 4; ++m) {
                const int row = row0 + ai * HALF + m * 16;
                bf16_t* xb = XB + (size_t)row * 1024 + col0; float ss = 0.f;
#pragma unroll
                for (int bj = 0; bj < 2; ++bj) {
                    const u32x4 xw = *(const u32x4*)(xb + bj * HALF);
                    f32x4 x0, x1;
                    x0[0] = __uint_as_float(xw.x << 16); x0[1] = __uint_as_float(xw.x & 0xffff0000u); x0[2] = __uint_as_float(xw.y << 16); x0[3] = __uint_as_float(xw.y & 0xffff0000u);
                    x1[0] = __uint_as_float(xw.z << 16); x1[1] = __uint_as_float(xw.z & 0xffff0000u); x1[2] = __uint_as_float(xw.w << 16); x1[3] = __uint_as_float(xw.w & 0xffff0000u);
                    x0 = x0 + acc[ai][bj][m][0] * alpha; x1 = x1 + acc[ai][bj][m][1] * alpha;
                    if (OUT) { float* xr = OUT + (size_t)row * 1024 + col0 + bj * HALF; *(f32x4*)xr = x0; *(f32x4*)(xr + 4) = x1; }
                    else {
                        u32x4 w; w.x = cvt_pk_bf16(x0[0], x0[1]); w.y = cvt_pk_bf16(x0[2], x0[3]); w.z = cvt_pk_bf16(x1[0], x1[1]); w.w = cvt_pk_bf16(x1[2], x1[3]);
                        *(u32x4*)(xb + bj * HALF) = w;
                        ss += (x0[0] * x0[0] + x0[1] * x0[1]) + (x0[2] * x0[2] + x0[3] * x0[3]) + (x1[0] * x1[0] + x1[1] * x1[1]) + (x1[2] * x1[2] + x1[3] * x1[3]);
                    }
                }
                if (!OUT) { ss += __shfl_xor(ss, 16); ss += __shfl_xor(ss, 32); if (fq == 0) ps[(size_t)row * 16 + u.pn * 4 + wc] = ss; }
            }
    }
};
struct EpiBf16 {
    static constexpr bool PERM = true, AFTER_DRAIN = false;
    bf16_t* O; bf16_t* O2; int ldc; const float* ps_in; int off4, n4; float inv_dim; float* ps_out; int mode; const float* gq; const float* gk; int nq, nke;
    __device__ __forceinline__ void operator()(const f32x4 (&acc)[2][2][4][2], const Unit& u, int wr, int wc, int fr, int fq) const {
        const int row0 = u.pm * BM + wr * 64 + fr, col0 = u.pn * BM + wc * 32 + 8 * fq;
        if (mode == 3) {
            const int t6 = u.pn % 6, ttype = t6 < nq ? 0 : (t6 < nke ? 1 : 2);
            float gv[2][8];
#pragma unroll
            for (int bj = 0; bj < 2; ++bj)
#pragma unroll
                for (int j = 0; j < 8; ++j) gv[bj][j] = ttype == 0 ? gq[32 * bj + 8 * fq + j] * (0.125f * 1.4426950408889634f) : (ttype == 1 ? gk[32 * bj + 8 * fq + j] : 1.f);
            const int colo = u.pn * BM + 64 * wc + 8 * fq;
#pragma unroll
            for (int ai = 0; ai < 2; ++ai)
#pragma unroll
                for (int m = 0; m < 4; ++m) {
                    const int row = row0 + ai * HALF + m * 16;
                    const float rs = rstd_from(ps_in, row, off4, n4, inv_dim, fq);
                    f32x4 v[2][2]; float ss = 0.f;
#pragma unroll
                    for (int bj = 0; bj < 2; ++bj) { v[bj][0] = acc[ai][bj][m][0] * rs; v[bj][1] = acc[ai][bj][m][1] * rs;
                        ss += (v[bj][0][0] * v[bj][0][0] + v[bj][0][1] * v[bj][0][1]) + (v[bj][0][2] * v[bj][0][2] + v[bj][0][3] * v[bj][0][3]) + (v[bj][1][0] * v[bj][1][0] + v[bj][1][1] * v[bj][1][1]) + (v[bj][1][2] * v[bj][1][2] + v[bj][1][3] * v[bj][1][3]); }
                    ss += __shfl_xor(ss, 16); ss += __shfl_xor(ss, 32);
                    const float rh = ttype < 2 ? rsqrtf(ss * (1.f / 64.f) + 1e-6f) : 1.f;
#pragma unroll
                    for (int bj = 0; bj < 2; ++bj) {
                        u32x4 w; w.x = cvt_pk_bf16(v[bj][0][0] * rh * gv[bj][0], v[bj][0][1] * rh * gv[bj][1]); w.y = cvt_pk_bf16(v[bj][0][2] * rh * gv[bj][2], v[bj][0][3] * rh * gv[bj][3]);
                        w.z = cvt_pk_bf16(v[bj][1][0] * rh * gv[bj][4], v[bj][1][1] * rh * gv[bj][5]); w.w = cvt_pk_bf16(v[bj][1][2] * rh * gv[bj][6], v[bj][1][3] * rh * gv[bj][7]);
                        *(u32x4*)(O + (size_t)row * ldc + colo + 32 * bj) = w;
                    }
                }
            return;
        }
#pragma unroll
        for (int ai = 0; ai < 2; ++ai)
#pragma unroll
            for (int m = 0; m < 4; ++m) {
                const int row = row0 + ai * HALF + m * 16;
                const float rs = rstd_from(ps_in, row, off4, n4, inv_dim, fq); float ss = 0.f;
#pragma unroll
                for (int bj = 0; bj < 2; ++bj) {
                    const f32x4 v0 = acc[ai][bj][m][0] * rs, v1 = acc[ai][bj][m][1] * rs; const int colg = col0 + bj * HALF;
                    bf16_t* dst;
                    if (mode == 2) { const int hh = colg >> 7, d = colg & 127; dst = d < 64 ? O + (size_t)row * 1536 + hh * 96 + d : O2 + (size_t)row * 1024 + hh * 64 + (d - 64); }
                    else dst = O + (size_t)row * ldc + colg;
                    u32x4 w; w.x = cvt_pk_bf16(v0[0], v0[1]); w.y = cvt_pk_bf16(v0[2], v0[3]); w.z = cvt_pk_bf16(v1[0], v1[1]); w.w = cvt_pk_bf16(v1[2], v1[3]);
                    *(u32x4*)dst = w;
                    ss += (v0[0] * v0[0] + v0[1] * v0[1]) + (v0[2] * v0[2] + v0[3] * v0[3]) + (v1[0] * v1[0] + v1[1] * v1[1]) + (v1[2] * v1[2] + v1[3] * v1[3]);
                }
                if (mode == 1) { ss += __shfl_xor(ss, 16); ss += __shfl_xor(ss, 32); if (fq == 0) ps_out[(size_t)row * 16 + u.pn * 4 + wc] = ss; }
            }
    }
};

template <class Epi, class Sched, bool ALIGN_EPI = false, bool SP2 = false>
__device__ __forceinline__ void gemm_phase(PG8_LAS unsigned char* lds, const Gemm g, const Sched& S, const Epi& E) {
    int tid_o = threadIdx.x; asm volatile("" : "+v"(tid_o));
    const int tid = tid_o, wid = __builtin_amdgcn_readfirstlane(tid >> 6), lane = tid & 63, wr = wid >> 2, wc = wid & 3, fr = lane & 15, fq = lane >> 4;
    const int K = g.K, nt = K / BK;
    unsigned voffA[2], voffB[2];
#pragma unroll
    for (int i = 0; i < 2; ++i) { int R, C; stage_rc(tid * 16 + i * 8192, R, C); const int Rb = Epi::PERM ? ((R & ~31) + perm32(R & 31)) : R;
        voffA[i] = (unsigned)(R * g.lda + C) * 2u; voffB[i] = (unsigned)(Rb * K + C) * 2u; }
    const size_t kstep = (size_t)(BK * 2);
    const size_t hstep = (size_t)HALF * K * 2;
    const size_t tstep = 2 * hstep; const size_t hstepA = (size_t)HALF * g.lda * 2, tstepA = 2 * hstepA;
    const unsigned ldsw = (unsigned)wid * 1024u;
    const int aoff = lds_byte(wr * 64 + fr, fq * 8), boff = lds_byte(wc * 32 + fr, fq * 8);
#define PG8_SA(b, h) (((b) * 2 + (h)) * HTB)
#define PG8_SB(b, h) ((4 + (b) * 2 + (h)) * HTB)
#define PG8_STAGE(bufoff, gbase, voff) do { _Pragma("unroll") for (int _i = 0; _i < 2; ++_i) \
        __builtin_amdgcn_global_load_lds((const unsigned*)((const char*)(gbase) + (voff)[_i]), (PG8_LAS unsigned*)(lds + (bufoff) + ldsw + _i * 8192), 16, 0, 0); } while (0)
#define PG8_LDA(dst, b, h) do { _Pragma("unroll") for (int m = 0; m < 4; ++m) _Pragma("unroll") for (int k = 0; k < 2; ++k) dst[m][k] = *(const PG8_LAS bf16x8*)(lds + PG8_SA(b, h) + aoff + m * 2048 + k * 1024); } while (0)
#define PG8_LDB(dst, b, h) do { _Pragma("unroll") for (int n = 0; n < 2; ++n) _Pragma("unroll") for (int k = 0; k < 2; ++k) dst[n][k] = *(const PG8_LAS bf16x8*)(lds + PG8_SB(b, h) + boff + n * 2048 + k * 1024); } while (0)
#define PG8_MMA(ai, bj, At, Bt) do { __builtin_amdgcn_s_setprio(1); _Pragma("unroll") for (int m = 0; m < 4; ++m) _Pragma("unroll") for (int n = 0; n < 2; ++n) _Pragma("unroll") for (int k = 0; k < 2; ++k) \
        acc[ai][bj][m][n] = __builtin_amdgcn_mfma_f32_16x16x32_bf16(Bt[n][k], At[m][k], acc[ai][bj][m][n], 0, 0, 0); __builtin_amdgcn_s_setprio(0); } while (0)
#define PG8_WAIT_V(n) asm volatile("s_waitcnt vmcnt(" #n ")" ::: "memory")
#define PG8_WAIT_L(n) asm volatile("s_waitcnt lgkmcnt(" #n ")" ::: "memory")
#define PG8_BAR __builtin_amdgcn_s_barrier()
#define PG8_SCHED __builtin_amdgcn_sched_barrier(0)
    Unit cur, nxt; int ui = 0;
    if (!S.next(0, cur)) return;
    f32x4 acc[2][2][4][2];
#pragma unroll
    for (int a = 0; a < 2; ++a)
#pragma unroll
        for (int b = 0; b < 2; ++b)
#pragma unroll
            for (int m = 0; m < 4; ++m)
#pragma unroll
                for (int n = 0; n < 2; ++n) acc[a][b][m][n] = (f32x4){0.f, 0.f, 0.f, 0.f};
    bf16x8 At[4][2], B0[2][2], B1[2][2];
    const char* cA = (const char*)g.A + (size_t)cur.pm * tstepA; const char* cB = (const char*)g.Bt + (size_t)cur.pn * tstep;
    S.a_ready(cur);
    if constexpr (SP2) {
        PG8_STAGE(PG8_SB(0, 0), cB, voffB); PG8_STAGE(PG8_SB(0, 1), cB + hstep, voffB); PG8_STAGE(PG8_SA(0, 0), cA, voffA); PG8_STAGE(PG8_SA(0, 1), cA + hstepA, voffA);
        if (wr == 1) PG8_BAR;
        PG8_WAIT_V(2); PG8_BAR;
        PG8_STAGE(PG8_SB(1, 0), cB + kstep, voffB); PG8_STAGE(PG8_SA(1, 0), cA + kstep, voffA); PG8_STAGE(PG8_SB(1, 1), cB + hstep + kstep, voffB);
        PG8_WAIT_V(6); PG8_BAR;
    } else {
        PG8_STAGE(PG8_SB(0, 0), cB, voffB); PG8_STAGE(PG8_SA(0, 0), cA, voffA); PG8_STAGE(PG8_SB(0, 1), cB + hstep, voffB); PG8_STAGE(PG8_SA(0, 1), cA + hstepA, voffA);
        if (wr == 1) PG8_BAR;
        PG8_WAIT_V(4); PG8_BAR;
        PG8_STAGE(PG8_SB(1, 0), cB + kstep, voffB); PG8_STAGE(PG8_SA(1, 0), cA + kstep, voffA); PG8_STAGE(PG8_SB(1, 1), cB + hstep + kstep, voffB);
        PG8_WAIT_V(6); PG8_BAR;
    }
    for (;;) {
        const bool has_next = S.next(ui + 1, nxt);
        const char* nA = has_next ? (const char*)g.A + (size_t)nxt.pm * tstepA : cA; const char* nB = has_next ? (const char*)g.Bt + (size_t)nxt.pn * tstep : cB;
        for (int t = 0; t < nt; t += 2) {
            const bool last = (t == nt - 2);
            const char* a1 = cA + (size_t)(t + 1) * kstep;
            const char* a2 = last ? nA : cA + (size_t)(t + 2) * kstep; const char* b2 = last ? nB : cB + (size_t)(t + 2) * kstep;
            const char* a3 = a2 + kstep; const char* b3 = b2 + kstep;
            if (last && has_next) S.a_ready(nxt);
            if constexpr (SP2) {
            PG8_LDB(B0, 0, 0); PG8_LDB(B1, 0, 1); PG8_SCHED; PG8_LDA(At, 0, 0); PG8_STAGE(PG8_SA(1, 1), a1 + hstepA, voffA);
            PG8_WAIT_V(8); PG8_WAIT_L(0); PG8_BAR; PG8_MMA(0, 0, At, B0); PG8_MMA(0, 1, At, B1); PG8_BAR; PG8_SCHED;
            PG8_LDA(At, 0, 1); PG8_STAGE(PG8_SB(0, 0), b2, voffB); PG8_STAGE(PG8_SB(0, 1), b2 + hstep, voffB); PG8_STAGE(PG8_SA(0, 0), a2, voffA);
            PG8_WAIT_V(8); PG8_WAIT_L(0); PG8_BAR; PG8_MMA(1, 0, At, B0); PG8_MMA(1, 1, At, B1); PG8_BAR; PG8_SCHED;
            PG8_LDB(B0, 1, 0); PG8_LDB(B1, 1, 1); PG8_SCHED; PG8_LDA(At, 1, 0); PG8_STAGE(PG8_SA(0, 1), a2 + hstepA, voffA);
            PG8_WAIT_V(8); PG8_WAIT_L(0); PG8_BAR; PG8_MMA(0, 0, At, B0); PG8_MMA(0, 1, At, B1); PG8_BAR; PG8_SCHED;
            PG8_LDA(At, 1, 1); PG8_STAGE(PG8_SB(1, 0), b3, voffB); PG8_STAGE(PG8_SB(1, 1), b3 + hstep, voffB); PG8_STAGE(PG8_SA(1, 0), a3, voffA);
            PG8_WAIT_V(8); PG8_WAIT_L(0); PG8_BAR; PG8_MMA(1, 0, At, B0); PG8_MMA(1, 1, At, B1); PG8_BAR; PG8_SCHED;
            } else {
            PG8_LDB(B0, 0, 0); PG8_SCHED; PG8_LDA(At, 0, 0); PG8_STAGE(PG8_SA(1, 1), a1 + hstepA, voffA);
            PG8_WAIT_L(8); PG8_BAR; PG8_WAIT_L(0); PG8_MMA(0, 0, At, B0); PG8_BAR; PG8_SCHED;
            PG8_LDB(B1, 0, 1); PG8_STAGE(PG8_SB(0, 0), b2, voffB);
            PG8_BAR; PG8_WAIT_L(0); PG8_MMA(0, 1, At, B1); PG8_BAR;
            PG8_LDA(At, 0, 1); PG8_STAGE(PG8_SA(0, 0), a2, voffA);
            PG8_BAR; PG8_WAIT_L(0); PG8_MMA(1, 0, At, B0); PG8_BAR; PG8_SCHED;
            PG8_STAGE(PG8_SB(0, 1), b2 + hstep, voffB);
            PG8_WAIT_V(6); PG8_BAR; PG8_MMA(1, 1, At, B1); PG8_BAR;
            PG8_LDB(B0, 1, 0); PG8_SCHED; PG8_LDA(At, 1, 0); PG8_STAGE(PG8_SA(0, 1), a2 + hstepA, voffA);
            PG8_WAIT_L(8); PG8_BAR; PG8_WAIT_L(0); PG8_MMA(0, 0, At, B0); PG8_BAR; PG8_SCHED;
            PG8_LDB(B1, 1, 1); PG8_STAGE(PG8_SB(1, 0), b3, voffB);
            PG8_BAR; PG8_WAIT_L(0); PG8_MMA(0, 1, At, B1); PG8_BAR;
            PG8_LDA(At, 1, 1); PG8_STAGE(PG8_SA(1, 0), a3, voffA);
            PG8_BAR; PG8_WAIT_L(0); PG8_MMA(1, 0, At, B0); PG8_BAR; PG8_SCHED;
            PG8_STAGE(PG8_SB(1, 1), b3 + hstep, voffB);
            PG8_WAIT_V(6); PG8_BAR; PG8_MMA(1, 1, At, B1); PG8_BAR;
            }
        }
        if constexpr (ALIGN_EPI) { if (wr == 0) PG8_BAR; }
        if constexpr (!Epi::AFTER_DRAIN) { E(acc, cur, wr, wc, fr, fq); S.done(cur); }
        if (!has_next) break;
#pragma unroll
        for (int a = 0; a < 2; ++a)
#pragma unroll
            for (int b = 0; b < 2; ++b)
#pragma unroll
                for (int m = 0; m < 4; ++m)
#pragma unroll
                    for (int n = 0; n < 2; ++n) acc[a][b][m][n] = (f32x4){0.f, 0.f, 0.f, 0.f};
        cur = nxt; cA = nA; cB = nB; ++ui;
        if constexpr (ALIGN_EPI) { if (wr == 1) PG8_BAR; }
    }
    PG8_WAIT_V(0);
    if constexpr (!ALIGN_EPI) { if (wr == 0) PG8_BAR; }
    PG8_BAR;
    if constexpr (Epi::AFTER_DRAIN) { E.fused(acc, cur, wr, wc, fr, fq, lds, wid, lane); S.done(cur); }
#undef PG8_SA
#undef PG8_SB
#undef PG8_STAGE
#undef PG8_LDA
#undef PG8_LDB
#undef PG8_MMA
#undef PG8_WAIT_V
#undef PG8_WAIT_L
#undef PG8_BAR
#undef PG8_SCHED
}
}
namespace att {
using pg8::bf16_t; using pg8::bf16x8; using pg8::f32x4; using pg8::u32x4;
typedef float f32x16 __attribute__((ext_vector_type(16)));
typedef short s16x4 __attribute__((ext_vector_type(4)));
typedef float f32x2_t __attribute__((ext_vector_type(2))); typedef __bf16 bf16x2_t __attribute__((ext_vector_type(2)));
#define ALAS __attribute__((address_space(3)))
constexpr float LOG2E = 1.4426950408889634f, LN2 = 0.6931471805599453f;
__device__ __forceinline__ unsigned cvtpk(float lo, float hi) { f32x2_t v = {lo, hi}; bf16x2_t b = __builtin_convertvector(v, bf16x2_t); return __builtin_bit_cast(unsigned, b); }
__device__ __forceinline__ float fadd_s(float a, float b) { float r; asm("v_add_f32_e32 %0, %1, %2" : "=v"(r) : "v"(a), "v"(b)); return r; }
__device__ __forceinline__ int crow(int i, int h) { return (i & 3) + 8 * (i >> 2) + 4 * h; }
__device__ __forceinline__ s16x4 vtr(const ALAS unsigned char* p) { return __builtin_bit_cast(s16x4, __builtin_amdgcn_ds_read_tr16_b64_v4i16((ALAS s16x4*)p)); }
#define AMFMA(a, b, c) __builtin_amdgcn_mfma_f32_32x32x16_bf16((a), (b), (c), 0, 0, 0)

struct AU {
    const bf16_t* Q; const bf16_t* K; const bf16_t* V; bf16_t* O; float* lse; const float* sink;
    long qrs, krs, vrs, ors, lrs;
    int q0, nsub, wph, qhs, ohs, band, hq0; float sl_scale, sl_exp; int r2;
};

template <bool SUB> __device__ __forceinline__ void attn_unit_r2(const AU& u, ALAS unsigned char* lds, float mb2) {
    constexpr int KP = 144, VP = 144, KBUF = 64 * KP, VBUF = 64 * VP, V_OFF = 2 * KBUF;
    int tid_o = threadIdx.x; asm volatile("" : "+v"(tid_o));
    const int tid = tid_o, lane = tid & 63, wid = __builtin_amdgcn_readfirstlane(tid >> 6), r = lane & 31, h = lane >> 5;
    const int hl = wid / u.wph, qs = u.q0 + 64 * (wid % u.wph);
    bf16x8 qa[4], qb[4];
    { const bf16_t* qp = u.Q + (size_t)hl * u.qhs + (size_t)(qs + r) * u.qrs + h * 8;
#pragma unroll
      for (int d0 = 0; d0 < 4; ++d0) { qa[d0] = *(const bf16x8*)(qp + d0 * 16); qb[d0] = *(const bf16x8*)(qp + (size_t)32 * u.qrs + d0 * 16); } }
    const int NT = u.nsub >> 6;
    const int kr0 = tid >> 3, kc0 = tid & 7;
    const bf16_t* kg0 = u.K + (size_t)kr0 * u.krs + kc0 * 8; const bf16_t* vg = u.V + (size_t)kr0 * u.vrs + kc0 * 8;
    const int kl0 = kr0 * KP + kc0 * 16, vl = V_OFF + kr0 * VP + kc0 * 16;
    f32x16 oa0, oa1, ob0, ob1, negm;
#pragma unroll
    for (int i = 0; i < 16; ++i) { oa0[i] = 0.f; oa1[i] = 0.f; ob0[i] = 0.f; ob1[i] = 0.f; negm[i] = SUB ? -mb2 : 0.f; }
    float la = 0.f, lb = 0.f;
    u32x4 rk = *(const u32x4*)kg0, rv = *(const u32x4*)vg;
    *(ALAS u32x4*)(lds + kl0) = rk; *(ALAS u32x4*)(lds + vl) = rv;
    __syncthreads();
    for (int t = 0; t < NT; ++t) {
        const int cur = t & 1;
        if (t + 1 < NT) { const size_t ro = (size_t)(t + 1) * 64; rk = *(const u32x4*)(kg0 + ro * u.krs); rv = *(const u32x4*)(vg + ro * u.vrs); }
        {
            const ALAS unsigned char* kb = lds + cur * KBUF + r * KP + h * 16;
            const ALAS unsigned char* vb = lds + V_OFF + cur * VBUF + (4 * h + ((lane & 15) >> 2)) * VP + ((lane >> 4) & 1) * 32 + (lane & 3) * 8;
            f32x16 Sa0 = negm, Sa1 = negm, Sb0 = negm, Sb1 = negm;
#pragma unroll
            for (int d0 = 0; d0 < 4; ++d0) {
                const bf16x8 k0 = *(const ALAS bf16x8*)(kb + d0 * 32), k1 = *(const ALAS bf16x8*)(kb + 32 * KP + d0 * 32);
                Sa0 = AMFMA(k0, qa[d0], Sa0); Sa1 = AMFMA(k1, qa[d0], Sa1); Sb0 = AMFMA(k0, qb[d0], Sb0); Sb1 = AMFMA(k1, qb[d0], Sb1);
            }
            bf16x8 paa[4], pab[4];
#define R2_SOFT(S0_, S1_, PA_, L_) do { float s0_ = 0.f, s1_ = 0.f; \
                _Pragma("unroll") for (int i = 0; i < 16; ++i) { S0_[i] = __builtin_amdgcn_exp2f(S0_[i]); S1_[i] = __builtin_amdgcn_exp2f(S1_[i]); } \
                __builtin_amdgcn_sched_barrier(0);     \
                _Pragma("unroll") for (int i = 0; i < 16; ++i) { s0_ += S0_[i]; s1_ += S1_[i]; } \
                L_ += s0_ + s1_; u32x4 w_; \
                w_.x = cvtpk(S0_[0], S0_[1]); w_.y = cvtpk(S0_[2], S0_[3]); w_.z = cvtpk(S0_[4], S0_[5]); w_.w = cvtpk(S0_[6], S0_[7]); PA_[0] = __builtin_bit_cast(bf16x8, w_); \
                w_.x = cvtpk(S0_[8], S0_[9]); w_.y = cvtpk(S0_[10], S0_[11]); w_.z = cvtpk(S0_[12], S0_[13]); w_.w = cvtpk(S0_[14], S0_[15]); PA_[1] = __builtin_bit_cast(bf16x8, w_); \
                w_.x = cvtpk(S1_[0], S1_[1]); w_.y = cvtpk(S1_[2], S1_[3]); w_.z = cvtpk(S1_[4], S1_[5]); w_.w = cvtpk(S1_[6], S1_[7]); PA_[2] = __builtin_bit_cast(bf16x8, w_); \
                w_.x = cvtpk(S1_[8], S1_[9]); w_.y = cvtpk(S1_[10], S1_[11]); w_.z = cvtpk(S1_[12], S1_[13]); w_.w = cvtpk(S1_[14], S1_[15]); PA_[3] = __builtin_bit_cast(bf16x8, w_); } while (0)
            R2_SOFT(Sa0, Sa1, paa, la);
            R2_SOFT(Sb0, Sb1, pab, lb);
#undef R2_SOFT
#pragma unroll
            for (int ks = 0; ks < 4; ++ks) {
                const s16x4 lo0 = vtr(vb + ks * 16 * VP), hi0 = vtr(vb + (ks * 16 + 8) * VP), lo1 = vtr(vb + ks * 16 * VP + 64), hi1 = vtr(vb + (ks * 16 + 8) * VP + 64);
                const bf16x8 vf0 = __builtin_shufflevector(lo0, hi0, 0, 1, 2, 3, 4, 5, 6, 7), vf1 = __builtin_shufflevector(lo1, hi1, 0, 1, 2, 3, 4, 5, 6, 7);
                oa0 = AMFMA(paa[ks], vf0, oa0); oa1 = AMFMA(paa[ks], vf1, oa1); ob0 = AMFMA(pab[ks], vf0, ob0); ob1 = AMFMA(pab[ks], vf1, ob1);
            }
        }
        if (t + 1 < NT) { *(ALAS u32x4*)(lds + (cur ^ 1) * KBUF + kl0) = rk; *(ALAS u32x4*)(lds + (cur ^ 1) * VBUF + vl) = rv; }
        __syncthreads();
    }
    la += __shfl_xor(la, 32); lb += __shfl_xor(lb, 32);
    const float ia = 1.f / la, ib = 1.f / lb;
    bf16_t* op = u.O + (size_t)hl * u.ohs + r;
#pragma unroll
    for (int i = 0; i < 16; ++i) { const int qi = crow(i, h); const float fa = __shfl(ia, qi), fb = __shfl(ib, qi);
        bf16_t* ra = op + (size_t)(qs + qi) * u.ors; bf16_t* rb = op + (size_t)(qs + 32 + qi) * u.ors;
        ra[0] = (bf16_t)(cvtpk(oa0[i] * fa, 0.f) & 0xffffu); ra[32] = (bf16_t)(cvtpk(oa1[i] * fa, 0.f) & 0xffffu);
        rb[0] = (bf16_t)(cvtpk(ob0[i] * fb, 0.f) & 0xffffu); rb[32] = (bf16_t)(cvtpk(ob1[i] * fb, 0.f) & 0xffffu);
        if ((i & 3) == 3) asm volatile("s_waitcnt vmcnt(0)" ::: "memory"); }
}

template <bool SUB> __device__ __forceinline__ void attn_unit_r2b(const AU& u, ALAS unsigned char* lds, float mb2) {
    constexpr int KP = 208, VP = 144, KBUF = 64 * KP, VBUF = 64 * VP, V_OFF = 2 * KBUF, QB_OFF = V_OFF + 2 * VBUF;
    int tid_o = threadIdx.x; asm volatile("" : "+v"(tid_o));
    const int tid = tid_o, lane = tid & 63, wid = __builtin_amdgcn_readfirstlane(tid >> 6), r = lane & 31, h = lane >> 5;
    const int qs = u.q0 + 64 * wid;
    bf16x8 qa[6];
    ALAS unsigned char* qbl = lds + QB_OFF + wid * 6144 + lane * 16;
    { const bf16_t* qp = u.Q + (size_t)(qs + r) * u.qrs + h * 8;
#pragma unroll
      for (int d0 = 0; d0 < 6; ++d0) { qa[d0] = *(const bf16x8*)(qp + d0 * 16); const bf16x8 t_ = *(const bf16x8*)(qp + (size_t)32 * u.qrs + d0 * 16); *(ALAS bf16x8*)(qbl + d0 * 1024) = t_; } }
    const int NT = u.nsub >> 6;
    const int kr0 = tid / 12, kc0 = tid - kr0 * 12, c1 = tid + 512, kr1 = c1 / 12, kc1 = c1 - kr1 * 12, vr_ = tid >> 3, vc_ = tid & 7;
    const bool k2 = tid < 256;
    const bf16_t* kg0 = u.K + (size_t)kr0 * u.krs + kc0 * 8; const bf16_t* kg1 = u.K + (size_t)kr1 * u.krs + kc1 * 8; const bf16_t* vg = u.V + (size_t)vr_ * u.vrs + vc_ * 8;
    const int kl0 = kr0 * KP + kc0 * 16, kl1 = kr1 * KP + kc1 * 16, vl = V_OFF + vr_ * VP + vc_ * 16;
    f32x16 oa0, oa1, ob0, ob1;
#pragma unroll
    for (int i = 0; i < 16; ++i) { oa0[i] = 0.f; oa1[i] = 0.f; ob0[i] = 0.f; ob1[i] = 0.f; }
    float la = 0.f, lb = 0.f;
    u32x4 rk0 = *(const u32x4*)kg0, rk1 = (u32x4){0u, 0u, 0u, 0u}, rv = *(const u32x4*)vg;
    if (k2) rk1 = *(const u32x4*)kg1;
    *(ALAS u32x4*)(lds + kl0) = rk0; if (k2) *(ALAS u32x4*)(lds + kl1) = rk1; *(ALAS u32x4*)(lds + vl) = rv;
    __syncthreads();
    for (int t = 0; t < NT; ++t) {
        const int cur = t & 1;
        if (t + 1 < NT) { const size_t ro = (size_t)(t + 1) * 64; rk0 = *(const u32x4*)(kg0 + ro * u.krs); if (k2) rk1 = *(const u32x4*)(kg1 + ro * u.krs); rv = *(const u32x4*)(vg + ro * u.vrs); }
        {
            const ALAS unsigned char* kb = lds + cur * KBUF + r * KP + h * 16;
            const ALAS unsigned char* vb = lds + V_OFF + cur * VBUF + (4 * h + ((lane & 15) >> 2)) * VP + ((lane >> 4) & 1) * 32 + (lane & 3) * 8;
            bf16x8 paa[4], pab[4];
            f32x16 Sa0, Sa1, Sb0, Sb1;
#pragma unroll
            for (int i = 0; i < 16; ++i) { Sa0[i] = 0.f; Sa1[i] = 0.f; Sb0[i] = 0.f; Sb1[i] = 0.f; }
#pragma unroll
            for (int d0 = 0; d0 < 6; ++d0) {
                const bf16x8 k0 = *(const ALAS bf16x8*)(kb + d0 * 32), k1 = *(const ALAS bf16x8*)(kb + 32 * KP + d0 * 32); const bf16x8 qbv = *(const ALAS bf16x8*)(qbl + d0 * 1024);
                Sa0 = AMFMA(k0, qa[d0], Sa0); Sa1 = AMFMA(k1, qa[d0], Sa1); Sb0 = AMFMA(k0, qbv, Sb0); Sb1 = AMFMA(k1, qbv, Sb1);
                if (d0 & 1) __builtin_amdgcn_sched_barrier(0);
            }
#define R2B_SOFT(S0_, S1_, PA_, L_) do { float s0_ = 0.f, s1_ = 0.f; \
                _Pragma("unroll") for (int i = 0; i < 16; ++i) { S0_[i] = __builtin_amdgcn_exp2f(SUB ? S0_[i] - mb2 : S0_[i]); S1_[i] = __builtin_amdgcn_exp2f(SUB ? S1_[i] - mb2 : S1_[i]); } \
                _Pragma("unroll") for (int i = 0; i < 16; ++i) { s0_ += S0_[i]; s1_ += S1_[i]; } \
                L_ += s0_ + s1_; u32x4 w_; \
                w_.x = cvtpk(S0_[0], S0_[1]); w_.y = cvtpk(S0_[2], S0_[3]); w_.z = cvtpk(S0_[4], S0_[5]); w_.w = cvtpk(S0_[6], S0_[7]); PA_[0] = __builtin_bit_cast(bf16x8, w_); \
                w_.x = cvtpk(S0_[8], S0_[9]); w_.y = cvtpk(S0_[10], S0_[11]); w_.z = cvtpk(S0_[12], S0_[13]); w_.w = cvtpk(S0_[14], S0_[15]); PA_[1] = __builtin_bit_cast(bf16x8, w_); \
                w_.x = cvtpk(S1_[0], S1_[1]); w_.y = cvtpk(S1_[2], S1_[3]); w_.z = cvtpk(S1_[4], S1_[5]); w_.w = cvtpk(S1_[6], S1_[7]); PA_[2] = __builtin_bit_cast(bf16x8, w_); \
                w_.x = cvtpk(S1_[8], S1_[9]); w_.y = cvtpk(S1_[10], S1_[11]); w_.z = cvtpk(S1_[12], S1_[13]); w_.w = cvtpk(S1_[14], S1_[15]); PA_[3] = __builtin_bit_cast(bf16x8, w_); } while (0)
            R2B_SOFT(Sa0, Sa1, paa, la);
            __builtin_amdgcn_sched_barrier(0);
            R2B_SOFT(Sb0, Sb1, pab, lb);
#undef R2B_SOFT
#pragma unroll
            for (int ks = 0; ks < 4; ++ks) {
                const s16x4 lo0 = vtr(vb + ks * 16 * VP), hi0 = vtr(vb + (ks * 16 + 8) * VP), lo1 = vtr(vb + ks * 16 * VP + 64), hi1 = vtr(vb + (ks * 16 + 8) * VP + 64);
                const bf16x8 vf0 = __builtin_shufflevector(lo0, hi0, 0, 1, 2, 3, 4, 5, 6, 7), vf1 = __builtin_shufflevector(lo1, hi1, 0, 1, 2, 3, 4, 5, 6, 7);
                oa0 = AMFMA(paa[ks], vf0, oa0); oa1 = AMFMA(paa[ks], vf1, oa1); ob0 = AMFMA(pab[ks], vf0, ob0); ob1 = AMFMA(pab[ks], vf1, ob1);
            }
        }
        if (t + 1 < NT) { *(ALAS u32x4*)(lds + (cur ^ 1) * KBUF + kl0) = rk0; if (k2) *(ALAS u32x4*)(lds + (cur ^ 1) * KBUF + kl1) = rk1; *(ALAS u32x4*)(lds + (cur ^ 1) * VBUF + vl) = rv; }
        __syncthreads();
    }
    la += __shfl_xor(la, 32); lb += __shfl_xor(lb, 32);
    const float ia = 1.f / la, ib = 1.f / lb;
    bf16_t* op = u.O + r;
#pragma unroll
    for (int i = 0; i < 16; ++i) { const int qi = crow(i, h); const float fa = __shfl(ia, qi), fb = __shfl(ib, qi);
        bf16_t* ra = op + (size_t)(qs + qi) * u.ors; bf16_t* rb = op + (size_t)(qs + 32 + qi) * u.ors;
        ra[0] = (bf16_t)(cvtpk(oa0[i] * fa, 0.f) & 0xffffu); ra[32] = (bf16_t)(cvtpk(oa1[i] * fa, 0.f) & 0xffffu);
        rb[0] = (bf16_t)(cvtpk(ob0[i] * fb, 0.f) & 0xffffu); rb[32] = (bf16_t)(cvtpk(ob1[i] * fb, 0.f) & 0xffffu);
        if ((i & 3) == 3) asm volatile("s_waitcnt vmcnt(0)" ::: "memory"); }
}

template <int DQ> __device__ __forceinline__ void attn_unit(const AU& u, ALAS unsigned char* lds, float mb2) {
    if constexpr (DQ == 64) { if (u.r2) { if (mb2 > 64.f) attn_unit_r2<true>(u, lds, mb2); else attn_unit_r2<false>(u, lds, mb2); return; } }
    if constexpr (DQ == 96) { if (u.r2) { if (mb2 > 64.f) attn_unit_r2b<true>(u, lds, mb2); else attn_unit_r2b<false>(u, lds, mb2); return; } }
    constexpr int KP = DQ * 2 + 16, VP = 144, NF = DQ / 16, CPR = DQ / 8, KBUF = 64 * KP, VBUF = 64 * VP, V_OFF = 2 * KBUF;
    int tid_o = threadIdx.x; asm volatile("" : "+v"(tid_o));
    const int tid = tid_o, lane = tid & 63, wid = __builtin_amdgcn_readfirstlane(tid >> 6), r = lane & 31, h = lane >> 5;
    const int hl = wid / u.wph, qs = u.q0 + 32 * (wid % u.wph);
    const bool wact = qs < u.nsub;
    bf16x8 qf[NF];
#pragma unroll
    for (int d0 = 0; d0 < NF; ++d0) qf[d0] = (bf16x8){0, 0, 0, 0, 0, 0, 0, 0};
    if (wact) { const bf16_t* qp = u.Q + (size_t)hl * u.qhs + (size_t)(qs + r) * u.qrs + h * 8;
#pragma unroll
        for (int d0 = 0; d0 < NF; ++d0) qf[d0] = *(const bf16x8*)(qp + d0 * 16); }
    const int RU = 32 * u.wph;
    int tlo = 0, thi = u.nsub >> 6;
    if (u.band) { const int a = u.q0 - u.band; tlo = a > 0 ? (a >> 6) : 0; const int b = ((u.q0 + RU - 1 + u.band) >> 6) + 1; thi = b < thi ? b : thi; }
    const float slope2 = u.sl_scale * exp2f(-u.sl_exp * (float)(u.hq0 + hl + 1));
    const int kr0 = tid / CPR, kc0 = tid - kr0 * CPR, c1 = tid + 512, kr1 = c1 / CPR, kc1 = c1 - kr1 * CPR;
    const bool k2 = (DQ == 96) && (tid < 256);
    const int vr_ = tid >> 3, vc_ = tid & 7;
    const bf16_t* kg0 = u.K + (size_t)kr0 * u.krs + kc0 * 8; const bf16_t* kg1 = u.K + (size_t)kr1 * u.krs + kc1 * 8; const bf16_t* vg = u.V + (size_t)vr_ * u.vrs + vc_ * 8;
    const int kl0 = kr0 * KP + kc0 * 16, kl1 = kr1 * KP + kc1 * 16, vl = V_OFF + vr_ * VP + vc_ * 16;
    f32x16 o0, o1, negm;
#pragma unroll
    for (int i = 0; i < 16; ++i) { o0[i] = 0.f; o1[i] = 0.f; negm[i] = -mb2; }
    float lsum = 0.f;
#define ATT_LOADK(t, S) do { const size_t ro_ = (size_t)(t) * 64; rk0##S = *(const u32x4*)(kg0 + ro_ * u.krs); if (k2) rk1##S = *(const u32x4*)(kg1 + ro_ * u.krs); } while (0)
#define ATT_LOADV(t, S) do { const size_t ro_ = (size_t)(t) * 64; rv##S = *(const u32x4*)(vg + ro_ * u.vrs); } while (0)
#define ATT_STOREK(b, S) do { *(ALAS u32x4*)(lds + (b) * KBUF + kl0) = rk0##S; if (k2) *(ALAS u32x4*)(lds + (b) * KBUF + kl1) = rk1##S; } while (0)
#define ATT_STOREV(b, S) do { *(ALAS u32x4*)(lds + (b) * VBUF + vl) = rv##S; } while (0)
#define ATT_SUMPACK4(X, B, PA) do { sacc = fadd_s(sacc, X[B]); sacc2 = fadd_s(sacc2, X[B + 1]); sacc = fadd_s(sacc, X[B + 2]); sacc2 = fadd_s(sacc2, X[B + 3]); sacc = fadd_s(sacc, X[B + 4]); sacc2 = fadd_s(sacc2, X[B + 5]); sacc = fadd_s(sacc, X[B + 6]); sacc2 = fadd_s(sacc2, X[B + 7]); \
        u32x4 w_; w_.x = cvtpk(X[B], X[B + 1]); w_.y = cvtpk(X[B + 2], X[B + 3]); w_.z = cvtpk(X[B + 4], X[B + 5]); w_.w = cvtpk(X[B + 6], X[B + 7]); PA = __builtin_bit_cast(bf16x8, w_); } while (0)
#define ATT_DENSE_BODY(t, P, Q) do { \
        if ((t) + 2 < NT) ATT_LOADK((t) + 2, P); if ((t) + 1 < NT) ATT_LOADV((t) + 1, Q); \
        if (wact) { \
            const ALAS unsigned char* kb = lds + (P) * KBUF + r * KP + h * 16; \
            const ALAS unsigned char* vb = lds + V_OFF + (Q) * VBUF + (4 * h + ((lane & 15) >> 2)) * VP + ((lane >> 4) & 1) * 32 + (lane & 3) * 8; \
            f32x16 S0 = negm, S1 = negm; bf16x8 pa[4]; float sacc = 0.f, sacc2 = 0.f; \
            _Pragma("unroll") for (int d0 = 0; d0 < NF; ++d0) { \
                const bf16x8 k0 = *(const ALAS bf16x8*)(kb + d0 * 32), k1 = *(const ALAS bf16x8*)(kb + 32 * KP + d0 * 32); \
                S0 = AMFMA(k0, qf[d0], S0); S1 = AMFMA(k1, qf[d0], S1); \
                if (d0 == 0) ATT_SUMPACK4(X0, 0, pa[0]); \
                if (d0 == 1) ATT_SUMPACK4(X0, 8, pa[1]); \
                if (d0 == 2) ATT_SUMPACK4(X1, 0, pa[2]); \
                if (d0 == 3) ATT_SUMPACK4(X1, 8, pa[3]); \
            } \
            lsum += sacc + sacc2; \
            _Pragma("unroll") for (int ks = 0; ks < 4; ++ks) { \
                const s16x4 lo0 = vtr(vb + ks * 16 * VP), hi0 = vtr(vb + (ks * 16 + 8) * VP), lo1 = vtr(vb + ks * 16 * VP + 64), hi1 = vtr(vb + (ks * 16 + 8) * VP + 64); \
                const bf16x8 vf0 = __builtin_shufflevector(lo0, hi0, 0, 1, 2, 3, 4, 5, 6, 7), vf1 = __builtin_shufflevector(lo1, hi1, 0, 1, 2, 3, 4, 5, 6, 7); \
                o0 = AMFMA(pa[ks], vf0, o0); o1 = AMFMA(pa[ks], vf1, o1); \
                _Pragma("unroll") for (int e = 0; e < 4; ++e) { X0[4 * ks + e] = __builtin_amdgcn_exp2f(S0[4 * ks + e]); X1[4 * ks + e] = __builtin_amdgcn_exp2f(S1[4 * ks + e]); } \
            } \
        } \
        if ((t) + 1 < NT) ATT_STOREK(Q, Q); ATT_STOREV(P, P); \
        __syncthreads(); } while (0)
    if (!u.band) {
        const int NT = u.nsub >> 6;
        u32x4 rk00, rk10 = (u32x4){0u, 0u, 0u, 0u}, rv0, rk01, rk11 = (u32x4){0u, 0u, 0u, 0u}, rv1;
        ATT_LOADK(0, 0); ATT_STOREK(0, 0);
        ATT_LOADK(1, 1); ATT_LOADV(0, 0);
        __syncthreads();
        f32x16 X0, X1;
#pragma unroll
        for (int i = 0; i < 16; ++i) { X0[i] = 0.f; X1[i] = 0.f; }
        {
            if (2 < NT) ATT_LOADK(2, 0); ATT_LOADV(1, 1);
            if (wact) {
                const ALAS unsigned char* kb = lds + r * KP + h * 16;
                f32x16 S0 = negm, S1 = negm;
#pragma unroll
                for (int d0 = 0; d0 < NF; ++d0) {
                    const bf16x8 k0 = *(const ALAS bf16x8*)(kb + d0 * 32), k1 = *(const ALAS bf16x8*)(kb + 32 * KP + d0 * 32);
                    S0 = AMFMA(k0, qf[d0], S0); S1 = AMFMA(k1, qf[d0], S1);
                }
#pragma unroll
                for (int i = 0; i < 16; ++i) { X0[i] = __builtin_amdgcn_exp2f(S0[i]); X1[i] = __builtin_amdgcn_exp2f(S1[i]); }
            }
            ATT_STOREK(1, 1); ATT_STOREV(0, 0);
            __syncthreads();
        }
        int t = 1;
        for (; t + 1 < NT; t += 2) { ATT_DENSE_BODY(t, 1, 0); ATT_DENSE_BODY(t + 1, 0, 1); }
        if (t < NT) ATT_DENSE_BODY(t, 1, 0);
        if (wact) {
            const ALAS unsigned char* vb = lds + V_OFF + ((NT - 1) & 1) * VBUF + (4 * h + ((lane & 15) >> 2)) * VP + ((lane >> 4) & 1) * 32 + (lane & 3) * 8;
            bf16x8 pa[4]; float sacc = 0.f, sacc2 = 0.f;
            ATT_SUMPACK4(X0, 0, pa[0]); ATT_SUMPACK4(X0, 8, pa[1]); ATT_SUMPACK4(X1, 0, pa[2]); ATT_SUMPACK4(X1, 8, pa[3]);
            lsum += sacc + sacc2;
#pragma unroll
            for (int ks = 0; ks < 4; ++ks) {
                const s16x4 lo0 = vtr(vb + ks * 16 * VP), hi0 = vtr(vb + (ks * 16 + 8) * VP), lo1 = vtr(vb + ks * 16 * VP + 64), hi1 = vtr(vb + (ks * 16 + 8) * VP + 64);
                const bf16x8 vf0 = __builtin_shufflevector(lo0, hi0, 0, 1, 2, 3, 4, 5, 6, 7), vf1 = __builtin_shufflevector(lo1, hi1, 0, 1, 2, 3, 4, 5, 6, 7);
                o0 = AMFMA(pa[ks], vf0, o0); o1 = AMFMA(pa[ks], vf1, o1);
            }
        }
        __syncthreads();
    } else if constexpr (DQ == 64) {
        constexpr int MAXT = 6, VB_OFF = MAXT * KBUF;
        const int nt = thi - tlo;
        u32x4 rk[MAXT], rv[MAXT];
#pragma unroll
        for (int i = 0; i < MAXT; ++i) if (i < nt) { const size_t ro_ = (size_t)(tlo + i) * 64; rk[i] = *(const u32x4*)(kg0 + ro_ * u.krs); rv[i] = *(const u32x4*)(vg + ro_ * u.vrs); }
#pragma unroll
        for (int i = 0; i < MAXT; ++i) if (i < nt) { *(ALAS u32x4*)(lds + i * KBUF + kl0) = rk[i]; *(ALAS u32x4*)(lds + VB_OFF + i * VBUF + (vl - V_OFF)) = rv[i]; }
        __syncthreads();
        for (int i = 0; i < nt; ++i) {
            const int t = tlo + i, tb = t * 64;
            if (!wact || tb + 63 < qs - u.band || tb > qs + 31 + u.band) continue;
            const ALAS unsigned char* kb = lds + i * KBUF + r * KP + h * 16;
            f32x16 p0 = negm, p1 = negm;
#pragma unroll
            for (int d0 = 0; d0 < NF; ++d0) {
                const bf16x8 k0 = *(const ALAS bf16x8*)(kb + d0 * 32), k1 = *(const ALAS bf16x8*)(kb + 32 * KP + d0 * 32);
                p0 = AMFMA(k0, qf[d0], p0); p1 = AMFMA(k1, qf[d0], p1);
            }
            const int rel_base = tb + 4 * h - (qs + r);
#pragma unroll
            for (int e = 0; e < 16; ++e) {
                const int rel0 = rel_base + (e & 3) + 8 * (e >> 2), rel1 = rel0 + 32;
                const int a0 = rel0 < 0 ? -rel0 : rel0, a1 = rel1 < 0 ? -rel1 : rel1;
                p0[e] = a0 <= u.band ? p0[e] - slope2 * (float)a0 : -INFINITY;
                p1[e] = a1 <= u.band ? p1[e] - slope2 * (float)a1 : -INFINITY;
            }
            float sacc = 0.f, sacc2 = 0.f;
#pragma unroll
            for (int e = 0; e < 16; ++e) { p0[e] = __builtin_amdgcn_exp2f(p0[e]); p1[e] = __builtin_amdgcn_exp2f(p1[e]); }
            bf16x8 pa[4];
            ATT_SUMPACK4(p0, 0, pa[0]); ATT_SUMPACK4(p0, 8, pa[1]); ATT_SUMPACK4(p1, 0, pa[2]); ATT_SUMPACK4(p1, 8, pa[3]);
            lsum += sacc + sacc2;
            const ALAS unsigned char* vb = lds + VB_OFF + i * VBUF + (4 * h + ((lane & 15) >> 2)) * VP + ((lane >> 4) & 1) * 32 + (lane & 3) * 8;
#pragma unroll
            for (int ks = 0; ks < 4; ++ks) {
                const s16x4 lo0 = vtr(vb + ks * 16 * VP), hi0 = vtr(vb + (ks * 16 + 8) * VP), lo1 = vtr(vb + ks * 16 * VP + 64), hi1 = vtr(vb + (ks * 16 + 8) * VP + 64);
                const bf16x8 vf0 = __builtin_shufflevector(lo0, hi0, 0, 1, 2, 3, 4, 5, 6, 7), vf1 = __builtin_shufflevector(lo1, hi1, 0, 1, 2, 3, 4, 5, 6, 7);
                o0 = AMFMA(pa[ks], vf0, o0); o1 = AMFMA(pa[ks], vf1, o1);
            }
        }
        __syncthreads();
    }
#undef ATT_LOADK
#undef ATT_LOADV
#undef ATT_STOREK
#undef ATT_STOREV
#undef ATT_SUMPACK4
#undef ATT_DENSE_BODY
    if (wact) {
        lsum += __shfl_xor(lsum, 32);
        if (u.sink) lsum += exp2f(u.sink[u.hq0 + hl] * LOG2E - mb2);
        const float linv = 1.f / lsum;
        bf16_t* op = u.O + (size_t)hl * u.ohs + r;
#pragma unroll
        for (int i = 0; i < 16; ++i) { const int qi = crow(i, h); const float f = __shfl(linv, qi); bf16_t* orow = op + (size_t)(qs + qi) * u.ors;
            orow[0] = (bf16_t)(cvtpk(o0[i] * f, 0.f) & 0xffffu); orow[32] = (bf16_t)(cvtpk(o1[i] * f, 0.f) & 0xffffu); }
        if (u.lse && h == 0) u.lse[(size_t)(qs + r) * u.lrs] = (mb2 + log2f(lsum)) * LN2;
    }
}

template <int DQ> __device__ __forceinline__ float logit_bound2(const float* gq, const float* gk, int lane) {
    float a = 0.f, b = 0.f;
    for (int i = lane; i < DQ; i += 64) { a = fmaxf(a, fabsf(gq[i])); b = fmaxf(b, fabsf(gk[i])); }
#pragma unroll
    for (int o = 1; o < 64; o <<= 1) { a = fmaxf(a, __shfl_xor(a, o)); b = fmaxf(b, __shfl_xor(b, o)); }
    return a * b * sqrtf((float)DQ) * LOG2E;
}
}

#define LAS __attribute__((address_space(3)))
typedef unsigned short bf16;
typedef unsigned v4u __attribute__((ext_vector_type(4)));
typedef float f32x4 __attribute__((ext_vector_type(4)));
constexpr int M = 32768, DM = 1024, FF = 2816, MP = 16384, SL = 2048;
constexpr size_t MiB = 1u << 20;
constexpr size_t WS_PS = 1 * MiB, WS_PS2 = 3 * MiB, WS_LSE = 5 * MiB, WS_W = 8 * MiB, WS_XB = 56 * MiB, WS_BIG = 120 * MiB, WS_END = 408 * MiB;
constexpr size_t W_UP0 = 0, W_DN0 = 11 * MiB, W_UP1 = 16 * MiB + MiB / 2, W_DN1 = 27 * MiB + MiB / 2, W_MIX = 33 * MiB;
constexpr int LDS_BYTES = 147456;
constexpr int NWAVES = 8;
constexpr float LOG2E = 1.4426950408889634f;

__device__ __forceinline__ unsigned f2bf(float f) { unsigned u = __builtin_bit_cast(unsigned, f); return (u + 0x7fffu + ((u >> 16) & 1u)) >> 16; }
__device__ __forceinline__ unsigned pk2(float lo, float hi) { return f2bf(lo) | (f2bf(hi) << 16); }
__device__ __forceinline__ float bflo(unsigned w) { return __uint_as_float(w << 16); }
__device__ __forceinline__ float bfhi(unsigned w) { return __uint_as_float(w & 0xffff0000u); }
__device__ __forceinline__ void ld8(const bf16* p, float (&v)[8]) { const v4u w = *(const v4u*)p; v[0] = bflo(w.x); v[1] = bfhi(w.x); v[2] = bflo(w.y); v[3] = bfhi(w.y); v[4] = bflo(w.z); v[5] = bfhi(w.z); v[6] = bflo(w.w); v[7] = bfhi(w.w); }
__device__ __forceinline__ void st8(bf16* p, const float (&v)[8]) { v4u w; w.x = pk2(v[0], v[1]); w.y = pk2(v[2], v[3]); w.z = pk2(v[4], v[5]); w.w = pk2(v[6], v[7]); *(v4u*)p = w; }
__device__ __forceinline__ float wave_sum(float v) {
#pragma unroll
    for (int o = 1; o < 64; o <<= 1) v += __shfl_xor(v, o);
    return v;
}

__device__ __forceinline__ void conv_item(const float* W, int K, int N, bf16* WT, int drow0, const float* g, LAS float* scr, int k0, int n0, int lane) {
#pragma unroll 8
    for (int i = 0; i < 32; ++i) { const int kk = 2 * i + (lane >> 5); float v = __builtin_nontemporal_load(W + (size_t)(k0 + kk) * N + n0 + (lane & 31)); if (g) v *= g[k0 + kk]; scr[kk * 33 + (lane & 31)] = v; }
    asm volatile("s_waitcnt lgkmcnt(0)" ::: "memory");
    const int c = lane & 7;
#pragma unroll
    for (int j = 0; j < 4; ++j) { const int n = (lane >> 3) + 8 * j; const LAS float* s = scr + (8 * c) * 33 + n;
        v4u o; o.x = pk2(s[0 * 33], s[1 * 33]); o.y = pk2(s[2 * 33], s[3 * 33]); o.z = pk2(s[4 * 33], s[5 * 33]); o.w = pk2(s[6 * 33], s[7 * 33]);
        *(v4u*)(WT + (size_t)(drow0 + n) * K + k0 + 8 * c) = o; }
    asm volatile("s_waitcnt lgkmcnt(0)" ::: "memory");
}
struct ConvD { const float* W; bf16* WT; const float* g; int K, N, dr, k0, n0; bool valid; };
__device__ __forceinline__ void conv_load(const ConvD& d, f32x4 (&v)[8], float (&gk)[8], int lane) {
    const int kr = lane >> 3, n4 = lane & 7;
#pragma unroll
    for (int i = 0; i < 8; ++i) { const int kk = 8 * i + kr; v[i] = __builtin_nontemporal_load((const f32x4*)(d.W + (size_t)(d.k0 + kk) * d.N + d.n0 + 4 * n4)); gk[i] = d.g ? d.g[d.k0 + kk] : 1.f; }
}
__device__ __forceinline__ void conv_finish(const ConvD& d, const f32x4 (&v)[8], const float (&gk)[8], LAS float* scr, int lane) {
    const int kr = lane >> 3, n4 = lane & 7;
#pragma unroll
    for (int i = 0; i < 8; ++i) { LAS float* p = scr + (8 * i + kr) * 33 + 4 * n4; p[0] = v[i][0] * gk[i]; p[1] = v[i][1] * gk[i]; p[2] = v[i][2] * gk[i]; p[3] = v[i][3] * gk[i]; }
    asm volatile("s_waitcnt lgkmcnt(0)" ::: "memory");
    const int c = lane & 7;
#pragma unroll
    for (int j = 0; j < 4; ++j) { const int n = (lane >> 3) + 8 * j; const LAS float* sp = scr + (8 * c) * 33 + n;
        v4u o; o.x = pk2(sp[0 * 33], sp[1 * 33]); o.y = pk2(sp[2 * 33], sp[3 * 33]); o.z = pk2(sp[4 * 33], sp[5 * 33]); o.w = pk2(sp[6 * 33], sp[7 * 33]);
        *(v4u*)(d.WT + (size_t)(d.dr + n) * d.K + d.k0 + 8 * c) = o; }
    asm volatile("s_waitcnt lgkmcnt(0)" ::: "memory");
}
#define CJD(Wp, K_, N_, WTp, gp, MODE, ROWOFF) if (!d.valid) { const int nblk_ = (N_) / 32, nit_ = ((K_) / 64) * nblk_; if (r < nit_) { const int kb_ = r / nblk_, nb_ = r - kb_ * nblk_, n0_ = 32 * nb_; \
    d.W = (Wp); d.K = (K_); d.N = (N_); d.WT = (WTp); d.g = (gp); d.k0 = 64 * kb_; d.n0 = n0_; d.valid = true; \
    d.dr = (MODE) == 1 ? 256 * (n0_ >> 7) + (n0_ & 127) + (ROWOFF) : ((MODE) == 2 ? 256 * (n0_ >> 8) + 128 * ((n0_ >> 5) & 1) + 32 * ((n0_ >> 6) & 3) + (ROWOFF) : n0_ + (ROWOFF)); } else r -= nit_; }
#define CJ(Wp, K_, N_, WTp, gp, MODE, ROWOFF) { const int nblk_ = (N_) / 32, nit_ = ((K_) / 64) * nblk_; if (r < nit_) { const int kb_ = r / nblk_, nb_ = r - kb_ * nblk_, n0_ = 32 * nb_; \
    const int dr_ = (MODE) == 1 ? 256 * (n0_ >> 7) + (n0_ & 127) + (ROWOFF) : ((MODE) == 2 ? 256 * (n0_ >> 8) + 128 * ((n0_ >> 5) & 1) + 32 * ((n0_ >> 6) & 3) + (ROWOFF) : n0_ + (ROWOFF)); conv_item((Wp), (K_), (N_), (WTp), dr_, (gp), scr, 64 * kb_, n0_, lane); continue; } r -= nit_; }

#define RLX_AGENT __ATOMIC_RELAXED, __HIP_MEMORY_SCOPE_AGENT
#define XB_TMO      128
#define XB_XCNT(j)  (256  + 64 * (j))
#define XB_XSUB(j)  (1280 + 64 * (j))
#define XB_XGEN(j)  (2304 + 64 * (j))
#define XB_TOP      3328
#define XB_TOPGEN   3392
#define XCD_BAR_WORDS 3456
#define XB_SPIN_CAP (1u << 18)

__device__ __forceinline__ unsigned xb_ld(unsigned* p)              { return __hip_atomic_load(p, __ATOMIC_RELAXED, __HIP_MEMORY_SCOPE_AGENT); }
__device__ __forceinline__ unsigned xb_add(unsigned* p, unsigned v) { return __hip_atomic_fetch_add(p, v, __ATOMIC_RELAXED, __HIP_MEMORY_SCOPE_AGENT); }
__device__ __forceinline__ unsigned xb_xcc_id() { return (unsigned)__builtin_amdgcn_s_getreg((3 << 11) | 20) & 0xFu; }
#define XB_SPIN(cond, bar) do { unsigned _sp = 0; while (cond) { __builtin_amdgcn_s_sleep(1); \
    if ((++_sp & 255u) == 0u) { if (xb_ld(&(bar)[XB_TMO])) break; if (_sp > XB_SPIN_CAP) { atomicAdd(&(bar)[XB_TMO], 1u); break; } } } } while (0)

struct XcdBarrier {
    unsigned* bar; unsigned x;
    volatile LAS unsigned* st;
};

__device__ __forceinline__ XcdBarrier xcd_barrier_post(unsigned* bar, volatile LAS unsigned* st) {
    XcdBarrier b; b.bar = bar; b.x = xb_xcc_id(); b.st = st;
    if (threadIdx.x == 0) (void)xb_add(&bar[XB_XCNT(b.x)], 1u);
    return b;
}
__device__ __forceinline__ void xcd_barrier_complete(unsigned* bar, unsigned x, unsigned& nloc, unsigned& nx) {
    const unsigned G = gridDim.x * gridDim.y * gridDim.z;
    unsigned sum, cnt, mine, sp = 0u;
    for (;;) {
        sum = 0u; cnt = 0u; mine = 0u;
#pragma unroll
        for (unsigned j = 0; j < 16; ++j) { const unsigned c = xb_ld(&bar[XB_XCNT(j)]); sum += c; cnt += (c > 0u) ? 1u : 0u; mine = (j == x) ? c : mine; }
        if (sum == G) break;
        __builtin_amdgcn_s_sleep(1);
        if ((++sp & 255u) == 0u) { if (xb_ld(&bar[XB_TMO])) break; if (sp > XB_SPIN_CAP) { atomicAdd(&bar[XB_TMO], 1u); break; } }
    }
    nloc = mine > 0u ? mine : 1u; nx = cnt > 0u ? cnt : 1u;
}

__device__ __forceinline__ void xcd_barrier(const XcdBarrier& b) {
    asm volatile("s_waitcnt vmcnt(0)" ::: "memory");
    __syncthreads();
    if (threadIdx.x == 0) {
        unsigned* bar = b.bar;
        __builtin_amdgcn_s_waitcnt(0);
        unsigned nloc = b.st[0], nx = b.st[1];
        if (nloc == 0u) { xcd_barrier_complete(bar, b.x, nloc, nx); b.st[0] = nloc; b.st[1] = nx; }
        const unsigned old = xb_add(&bar[XB_XSUB(b.x)], 1u);
        const unsigned gen = old / nloc;
        if (old + 1u == (gen + 1u) * nloc) {
            __builtin_amdgcn_fence(__ATOMIC_RELEASE, "agent");
            asm volatile("s_waitcnt vmcnt(0)" ::: "memory");
            const unsigned og = xb_add(&bar[XB_TOP], 1u);
            const unsigned tg = og / nx;
            if (og + 1u == (tg + 1u) * nx) xb_add(&bar[XB_TOPGEN], 1u);
            else XB_SPIN(xb_ld(&bar[XB_TOPGEN]) == tg, bar);
            __builtin_amdgcn_fence(__ATOMIC_ACQUIRE, "agent");
            xb_add(&bar[XB_XGEN(b.x)], 1u);
            asm volatile("s_waitcnt vmcnt(0)" ::: "memory");
        } else {
            XB_SPIN(xb_ld(&bar[XB_XGEN(b.x)]) == gen, bar);
            __builtin_amdgcn_fence(__ATOMIC_ACQUIRE, "agent");
            asm volatile("s_waitcnt vmcnt(0)" ::: "memory");
        }
    }
    __syncthreads();
}

struct Args { const float* in[33]; float* out; unsigned char* ws; };

__device__ __forceinline__ void conv_phase(const Args& a, int L, LAS unsigned char* lds, int gw, int NGW, int lane, int wave) {
    LAS float* scr = (LAS float*)(lds + wave * 16384);
    bf16* Wb = (bf16*)(a.ws + WS_W);
    const size_t so = (size_t)L * DM * FF;
    const float* g1 = a.in[2] + L * DM; const float* gm = a.in[6] + L * DM; const float* g2 = a.in[7] + L * DM;
    bf16* up0 = Wb + W_UP0 / 2; bf16* dn0 = Wb + W_DN0 / 2; bf16* up1 = Wb + W_UP1 / 2; bf16* dn1 = Wb + W_DN1 / 2; bf16* mix = Wb + W_MIX / 2;
#define CONV_DECODE(dd, item) do { ConvD d; d.valid = false; d.W = nullptr; d.WT = nullptr; d.g = nullptr; d.K = 0; d.N = 0; d.dr = 0; d.k0 = 0; d.n0 = 0; int r = (item); \
        if (r < 16384) { \
        CJD(a.in[3] + so, DM, FF, up0, g1, 1, 0) \
        CJD(a.in[4] + so, DM, FF, up0, g1, 1, 128) \
        CJD(a.in[5] + so, FF, DM, dn0, (const float*)nullptr, 0, 0) \
        CJD(a.in[8] + so, DM, FF, up1, g2, 1, 0) \
        CJD(a.in[9] + so, DM, FF, up1, g2, 1, 128) \
        CJD(a.in[10] + so, FF, DM, dn1, (const float*)nullptr, 0, 0) \
        if (L == 0) { \
            CJD(a.in[11], DM, 1536, mix, gm, 2, 0) \
            CJD(a.in[15], DM, DM, mix + 3 * MiB / 2, (const float*)nullptr, 0, 0) \
        } else if (L == 1) { \
            CJD(a.in[16], DM, 512, mix, gm, 0, 0) \
            CJD(a.in[19], DM, 288, mix, gm, 0, 512) \
            CJD(a.in[18], 512, 1536, mix + 2 * MiB / 2, a.in[17], 0, 0) \
            CJD(a.in[21], 256, 2048, mix + (3 * MiB + MiB / 2) / 2, a.in[20], 0, 0) \
            CJD(a.in[24], DM, DM, mix + (4 * MiB + MiB / 2) / 2, (const float*)nullptr, 0, 0) \
        } else if (L == 2) { \
            CJD(a.in[25], DM, 4608, mix, gm, 2, 0) \
            CJD(a.in[28], 512, DM, mix + 9 * MiB / 2, (const float*)nullptr, 0, 0) \
        } else { \
            CJD(a.in[29], DM, 1536, mix, gm, 0, 0) \
            CJD(a.in[32], DM, DM, mix + 3 * MiB / 2, (const float*)nullptr, 0, 0) \
        } } \
        dd = d; } while (0)
    {
        f32x4 va[8], vb[8]; float ga[8], gb[8]; ConvD d0, d1;
        int it = gw;
        CONV_DECODE(d0, it);
        if (d0.valid) {
            conv_load(d0, va, ga, lane);
            for (;;) {
                CONV_DECODE(d1, it + NGW); if (d1.valid) conv_load(d1, vb, gb, lane);
                conv_finish(d0, va, ga, scr, lane);
                if (!d1.valid) break;
                it += 2 * NGW;
                CONV_DECODE(d0, it); if (d0.valid) conv_load(d0, va, ga, lane);
                conv_finish(d1, vb, gb, scr, lane);
                if (!d0.valid) break;
            }
        }
    }
#undef CONV_DECODE
    if (L == 1) {
        v4u* z = (v4u*)(mix + (size_t)800 * 1024);
        for (int i = gw * 64 + lane; i < 224 * 1024 / 8; i += NGW * 64) z[i] = (v4u){0u, 0u, 0u, 0u};
    }
    if (L == 0) {
        bf16* XB = (bf16*)(a.ws + WS_XB); float* PS = (float*)(a.ws + WS_PS);
        for (int row = gw; row < M; row += NGW) {
            const float* src = row < MP ? a.in[0] + (size_t)row * DM : a.in[1] + (size_t)(row - MP) * DM;
            const f32x4* xr = (const f32x4*)src + lane; unsigned long long* xb = (unsigned long long*)(XB + (size_t)row * DM) + lane;
            float ss = 0.f;
#pragma unroll
            for (int j = 0; j < 4; ++j) { const f32x4 v = __builtin_nontemporal_load(xr + 64 * j); ss += (v[0] * v[0] + v[1] * v[1]) + (v[2] * v[2] + v[3] * v[3]);
                xb[64 * j] = (unsigned long long)pk2(v[0], v[1]) | ((unsigned long long)pk2(v[2], v[3]) << 32); }
            ss = wave_sum(ss);
            if (lane < 16) PS[(size_t)row * 16 + lane] = lane == 0 ? ss : 0.f;
        }
    }
}

__device__ __forceinline__ int seq_pos(int row) { return row < MP ? row : ((row - MP) & (SL - 1)); }

__device__ __forceinline__ void prep64(bf16* buf, int kind, const float* gq, const float* gk, int gw, int NGW, int lane) {
    const int pitch = kind == 2 ? 4608 : 1536, nvec = kind == 2 ? 48 : 20, c = lane & 7, grp = lane >> 3;
    float gqv[8], gkv[8], inv[8];
#pragma unroll
    for (int e = 0; e < 8; ++e) { gqv[e] = gq[8 * c + e] * (0.125f * LOG2E); gkv[e] = gk[8 * c + e]; inv[e] = powf(10000.f, -(float)(8 * (c & 1) + e) * (1.f / 16.f)); }
    for (int tb = gw; tb < M / 8; tb += NGW) {
        const int row = tb * 8 + grp;
        bf16* rp = buf + (size_t)row * pitch + 8 * c;
        float cs[8], sn[8];
        if (kind == 3) { const int t = seq_pos(row); const float pos = (float)((c & 4) ? (t & 63) : (t >> 6));
#pragma unroll
            for (int e = 0; e < 8; ++e) { const float ang = pos * inv[e]; cs[e] = cosf(ang); sn[e] = sinf(ang); } }
        for (int v0 = 0; v0 < nvec; v0 += 4) {
            float v[4][8];
#pragma unroll
            for (int j = 0; j < 4; ++j) { const int vi = v0 + j; ld8(rp + (kind == 2 ? 1536 * (vi >> 4) + 64 * (vi & 15) : 64 * vi), v[j]); }
#pragma unroll
            for (int j = 0; j < 4; ++j) {
                const int vi = v0 + j; const bool isq = kind == 2 ? ((vi & 15) < 8) : (vi < 16);
                float ss = 0.f;
#pragma unroll
                for (int e = 0; e < 8; ++e) ss += v[j][e] * v[j][e];
                ss += __shfl_xor(ss, 1); ss += __shfl_xor(ss, 2); ss += __shfl_xor(ss, 4);
                const float rs = rsqrtf(ss * (1.f / 64.f) + 1e-6f);
#pragma unroll
                for (int e = 0; e < 8; ++e) v[j][e] = v[j][e] * rs;
                if (kind == 3) {
#pragma unroll
                    for (int e = 0; e < 8; ++e) { const float mine = v[j][e] * (isq ? gqv[e] : gkv[e]); const float other = __shfl_xor(mine, 2); v[j][e] = (c & 2) ? other * sn[e] + mine * cs[e] : mine * cs[e] - other * sn[e]; }
                } else {
#pragma unroll
                    for (int e = 0; e < 8; ++e) v[j][e] *= (isq ? gqv[e] : gkv[e]);
                }
            }
#pragma unroll
            for (int j = 0; j < 4; ++j) { const int vi = v0 + j; st8(rp + (kind == 2 ? 1536 * (vi >> 4) + 64 * (vi & 15) : 64 * vi), v[j]); }
        }
    }
}

__device__ __forceinline__ void prep_mla(bf16* Qraw, bf16* Kb, const bf16* CQ, const float* gq, const float* gk, int gw, int NGW, int lane) {
    const int c = lane & 15, grp = lane >> 4; const bool live = c < 12, rot = c >= 8 && c < 12;
    float gqv[8], gkv[8], inv[8];
#pragma unroll
    for (int e = 0; e < 8; ++e) { gqv[e] = live ? gq[8 * c + e] * (0.10206207261596575f * LOG2E) : 0.f; gkv[e] = live ? gk[8 * c + e] : 0.f; inv[e] = powf(10000.f, -(float)(8 * (c & 1) + e) * (1.f / 16.f)); }
    for (int tb = gw; tb < M / 4; tb += NGW) {
        const int row = tb * 4 + grp;
        const float pos = (float)seq_pos(row);
        float cs[8], sn[8];
#pragma unroll
        for (int e = 0; e < 8; ++e) { const float ang = pos * inv[e]; cs[e] = cosf(ang); sn[e] = sinf(ang); }
        float kr[8];
#pragma unroll
        for (int e = 0; e < 8; ++e) kr[e] = 0.f;
        if (rot) ld8(CQ + (size_t)row * 1024 + 768 + 8 * (c - 8), kr);
        bf16* qrow = Qraw + (size_t)row * 1536 + 8 * c; bf16* krow = Kb + (size_t)row * 1536 + 8 * c;
        for (int h0 = 0; h0 < 16; h0 += 2) {
            float v[4][8];
#pragma unroll
            for (int j = 0; j < 4; ++j) {
                const int hh = h0 + (j >> 1); const bool isk = j & 1;
#pragma unroll
                for (int e = 0; e < 8; ++e) v[j][e] = 0.f;
                if (isk) { if (c < 8) ld8(krow + hh * 96, v[j]); else {
#pragma unroll
                        for (int e = 0; e < 8; ++e) v[j][e] = kr[e]; } }
                else if (live) ld8(qrow + hh * 96, v[j]);
            }
#pragma unroll
            for (int j = 0; j < 4; ++j) {
                const bool isk = j & 1;
                float ss = 0.f;
#pragma unroll
                for (int e = 0; e < 8; ++e) ss += v[j][e] * v[j][e];
                ss += __shfl_xor(ss, 1); ss += __shfl_xor(ss, 2); ss += __shfl_xor(ss, 4); ss += __shfl_xor(ss, 8);
                const float rs = rsqrtf(ss * (1.f / 96.f) + 1e-6f);
#pragma unroll
                for (int e = 0; e < 8; ++e) { const float mine = v[j][e] * rs * (isk ? gkv[e] : gqv[e]); const float other = __shfl_xor(mine, 2);
                    v[j][e] = rot ? ((c & 2) ? other * sn[e] + mine * cs[e] : mine * cs[e] - other * sn[e]) : mine; }
            }
#pragma unroll
            for (int j = 0; j < 4; ++j) { const int hh = h0 + (j >> 1); if (live) st8(((j & 1) ? krow : qrow) + hh * 96, v[j]); }
        }
    }
}

__device__ __forceinline__ void merge_c(bf16* buf, const float* LSE, int gw, int NGW, int lane) {
    const int hh = lane >> 3, c = lane & 7;
    for (int row = gw; row < M; row += NGW) {
        const float l0 = LSE[((size_t)0 * M + row) * 8 + hh], l1 = LSE[((size_t)1 * M + row) * 8 + hh], l2 = LSE[((size_t)2 * M + row) * 8 + hh];
        const float mx = fmaxf(l0, fmaxf(l1, l2)); const float e0 = __expf(l0 - mx), e1 = __expf(l1 - mx), e2 = __expf(l2 - mx); const float inv = 1.f / (e0 + e1 + e2);
        bf16* rp = buf + (size_t)row * 4608 + hh * 64 + 8 * c;
        float a[8], b[8], d[8], o[8]; ld8(rp, a); ld8(rp + 1536, b); ld8(rp + 3072, d);
#pragma unroll
        for (int e = 0; e < 8; ++e) o[e] = (a[e] * e0 + b[e] * e1 + d[e] * e2) * inv;
        st8(rp + 512, o);
    }
}

struct DecAD {
    bf16* buf; const float* sink; int band; bf16* obase; int opitch; int r2;
    __device__ __forceinline__ att::AU operator()(int list, int ui) const {
        int kvh, blk, base, nsub;
        if (list == 0) { kvh = ui >> 8; blk = ui & 255; base = 0; nsub = MP; } else { const int b = ui >> 7; kvh = (ui >> 5) & 3; blk = ui & 31; base = MP + b * SL; nsub = SL; }
        att::AU u; bf16* q = buf + (size_t)base * 1536 + kvh * 256;
        u.Q = q; u.O = obase ? obase + (size_t)base * opitch + kvh * 256 : q; u.K = buf + (size_t)base * 1536 + 1024 + kvh * 64; u.V = buf + (size_t)base * 1536 + 1280 + kvh * 64; u.lse = nullptr; u.sink = sink;
        u.qrs = u.krs = u.vrs = 1536; u.ors = obase ? opitch : 1536; u.lrs = 0; u.q0 = blk * 64; u.nsub = nsub; u.wph = 2; u.qhs = u.ohs = 64; u.band = band; u.hq0 = kvh * 4; u.sl_scale = att::LOG2E; u.sl_exp = 0.5f; u.r2 = r2;
        if (r2) { if (list == 0) { kvh = ui >> 7; blk = ui & 127; } else { const int b = ui >> 6; kvh = (ui >> 4) & 3; blk = ui & 15; base = MP + b * SL; }
            bf16* q2 = buf + (size_t)base * 1536 + kvh * 256; u.Q = q2; u.O = obase ? obase + (size_t)base * opitch + kvh * 256 : q2; u.K = buf + (size_t)base * 1536 + 1024 + kvh * 64; u.V = buf + (size_t)base * 1536 + 1280 + kvh * 64; u.q0 = blk * 128; u.hq0 = kvh * 4; }
        return u;
    }
};
struct DecB {
    const bf16* Q; const bf16* K; const bf16* V; bf16* O;
    __device__ __forceinline__ att::AU operator()(int list, int ui) const {
        int hh, blk, base, nsub;
        if (list == 0) { hh = ui >> 6; blk = ui & 63; base = 0; nsub = MP; } else { const int b = ui >> 7; hh = (ui >> 3) & 15; blk = ui & 7; base = MP + b * SL; nsub = SL; }
        att::AU u; u.Q = Q + (size_t)base * 1536 + hh * 96; u.K = K + (size_t)base * 1536 + hh * 96; u.V = V + (size_t)base * 1024 + hh * 64; u.O = O + (size_t)base * 1024 + hh * 64; u.lse = nullptr; u.sink = nullptr;
        u.qrs = u.krs = 1536; u.vrs = u.ors = 1024; u.lrs = 0; u.q0 = blk * 256; u.nsub = nsub; u.wph = 8; u.qhs = u.ohs = 0; u.band = 0; u.hq0 = hh; u.sl_scale = 0.f; u.sl_exp = 0.f; u.r2 = 1;
        { int hh2, blk2, base2; if (list == 0) { hh2 = ui >> 5; blk2 = ui & 31; base2 = 0; } else { const int b2 = ui >> 6; hh2 = (ui >> 2) & 15; blk2 = ui & 3; base2 = MP + b2 * SL; }
          u.Q = Q + (size_t)base2 * 1536 + hh2 * 96; u.K = K + (size_t)base2 * 1536 + hh2 * 96; u.V = V + (size_t)base2 * 1024 + hh2 * 64; u.O = O + (size_t)base2 * 1024 + hh2 * 64; u.q0 = blk2 * 512; u.hq0 = hh2; }
        return u;
    }
};
struct DecC {
    bf16* buf; float* LSE;
    __device__ __forceinline__ att::AU operator()(int list, int ui) const {
        int g, hh, blk, rr, base, len;
        if (list == 0) { g = ui >> 9; const int w = ui & 511, nbs = 6 - 2 * g; blk = w & ((1 << nbs) - 1); hh = (w >> nbs) & 7; rr = w >> (nbs + 3); base = 0; len = MP; }
        else { const int sq = ui >> 8; int w = ui & 255; base = MP + sq * SL; len = SL;
            if (w < 64) { g = 0; hh = w >> 3; blk = w & 7; rr = 0; } else if (w < 128) { w -= 64; g = 1; blk = w & 1; hh = (w >> 1) & 7; rr = w >> 4; } else { w -= 128; g = 2; blk = 0; hh = w & 7; rr = w >> 3; } }
        const int dil = 1 << (2 * g), t0 = base + rr;
        att::AU u; bf16* q = buf + (size_t)t0 * 4608 + g * 1536 + hh * 64;
        u.Q = q; u.O = q; u.K = q + 512; u.V = q + 1024; u.lse = LSE + ((size_t)g * M + t0) * 8 + hh; u.sink = nullptr;
        u.qrs = u.krs = u.vrs = u.ors = (long)dil * 4608; u.lrs = 8 * dil; u.q0 = blk * 256; u.nsub = len >> (2 * g); u.wph = 8; u.qhs = u.ohs = 0; u.band = 64; u.hq0 = hh; u.sl_scale = att::LOG2E * (float)dil; u.sl_exp = 1.0f; u.r2 = 0;
        return u;
    }
};
template <int DQ, class Dec> __device__ __forceinline__ void attn_phase(LAS unsigned char* lds, int G, int vcu, int n0, int n1, const Dec& dec, float mb2) {
    for (int list = 0; list < 2; ++list) {
        const int n = list ? n1 : n0, per = (n + G - 1) / G;
        for (int i = 0; i < per; ++i) { const int ui = vcu * per + i; if (ui < n) { const att::AU u = dec(list, ui); att::attn_unit<DQ>(u, lds, mb2); } }
    }
}

enum Kind { K_NOP = 0, K_CONV, K_SWIGLU, K_RES, K_BF16, K_PREP, K_ATTN, K_MERGE };

__global__ void __launch_bounds__(NWAVES * 64, 2) fwd_megakernel(Args a) {
    extern __shared__ __attribute__((aligned(16))) unsigned char lds_raw[];
    LAS unsigned char* lds = (LAS unsigned char*)lds_raw;
    cg::grid_group grid = cg::this_grid();
    for (int u_ = threadIdx.x; u_ < (LDS_BYTES - 131072) / 4; u_ += NWAVES * 64) ((LAS unsigned*)(lds + 131072))[u_] = 0u;
    __syncthreads();
    const XcdBarrier xbar = xcd_barrier_post((unsigned*)a.ws, (volatile LAS unsigned*)(lds + 131072 + 320) + 8);
    const int G = gridDim.x, bx = blockIdx.x, vcu = (G % 8 == 0) ? (bx % 8) * (G / 8) + bx / 8 : bx;
    const int NGW = G * NWAVES;
    unsigned char* ws = a.ws;
    float* PS = (float*)(ws + WS_PS); float* PS2 = (float*)(ws + WS_PS2); float* LSE = (float*)(ws + WS_LSE);
    bf16* Wb = (bf16*)(ws + WS_W); bf16* XB = (bf16*)(ws + WS_XB); bf16* BIG = (bf16*)(ws + WS_BIG);
    bf16* mix = Wb + W_MIX / 2;
    bf16* QRAW = BIG + 32 * MiB;
    bf16* KB = BIG + 80 * MiB;

#ifdef PROBE_UP2
    constexpr int SPL = 14, S_UP0 = 1, S_UP0B = 2, S_DN0 = 3, S_MIX0 = 4, S_UP1 = 11, S_UP1B = 12, S_DN1 = 13;
#else
    constexpr int SPL = 12, S_UP0 = 1, S_UP0B = -1, S_DN0 = 2, S_MIX0 = 3, S_UP1 = 10, S_UP1B = -1, S_DN1 = 11;
#endif
    for (int step = 0; step < 4 * SPL; ++step) {
        int tid_o = threadIdx.x; asm volatile("" : "+v"(tid_o));
        const int lane = tid_o & 63, wave = __builtin_amdgcn_readfirstlane(tid_o >> 6), gw = vcu * NWAVES + wave;
        const int L = step / SPL, s = step - L * SPL;
        int kind = K_NOP; bool nosync = false;
        pg8::Gemm g; g.A = nullptr; g.Bt = nullptr; g.M = M; g.N = 0; g.K = 0; g.lda = 0;
        float alpha = 1.f;
        pg8::EpiBf16 eb; eb.O = BIG; eb.O2 = XB; eb.ldc = 0; eb.ps_in = PS; eb.off4 = 0; eb.n4 = 4; eb.inv_dim = 1.f / 1024.f; eb.ps_out = PS2; eb.mode = 0; eb.gq = nullptr; eb.gk = nullptr; eb.nq = 0; eb.nke = 0;
        if (s == 0) kind = K_CONV;
        else if (s == S_UP0 || s == S_UP0B || s == S_UP1 || s == S_UP1B) { kind = K_SWIGLU; g.A = XB; g.lda = DM; g.Bt = Wb + (s < S_MIX0 ? W_UP0 : W_UP1) / 2; g.N = 2 * FF; g.K = DM; }
        else if (s == S_DN0 || s == S_DN1) { kind = K_RES; g.A = BIG; g.lda = FF; g.Bt = Wb + (s == S_DN0 ? W_DN0 : W_DN1) / 2; g.N = DM; g.K = FF; alpha = 0.5f; }
        else {
            int k = s - S_MIX0;
#ifdef PROBE_ATTN2
            if (L == 1 && k >= 5) k -= 1;
            if (L == 3 && k >= 3) k -= 1;
#else
            if (k == 6) k = 7;
#endif
            if (L == 0 || L == 3) {
                if (k == 0) { kind = K_BF16; g.A = XB; g.lda = DM; g.Bt = mix; g.N = 1536; g.K = DM; eb.ldc = 1536; if (L == 0) { eb.mode = 3; eb.gq = a.in[12]; eb.gk = a.in[13]; eb.nq = 4; eb.nke = 5; } }
                else if (k == 1) { if (L == 3) kind = K_PREP; }
                else if (k == 2) kind = K_ATTN;
                else if (k == 3) { kind = K_RES; g.A = L == 0 ? BIG : BIG + 48 * MiB; g.lda = L == 0 ? 1536 : 1024; g.Bt = mix + 3 * MiB / 2; g.N = DM; g.K = DM; }
            } else if (L == 1) {
                if (k == 0) { kind = K_BF16; g.A = XB; g.lda = DM; g.Bt = mix; g.N = 1024; g.K = DM; eb.ldc = 1024; eb.mode = 1; }
                else if (k == 1) { kind = K_BF16; nosync = true; g.A = BIG; g.lda = 1024; g.Bt = mix + 2 * MiB / 2; g.N = 1536; g.K = 512; eb.O = QRAW; eb.ldc = 1536; eb.ps_in = PS2; eb.off4 = 0; eb.n4 = 2; eb.inv_dim = 1.f / 512.f; }
                else if (k == 2) { kind = K_BF16; g.A = BIG + 512; g.lda = 1024; g.Bt = mix + (3 * MiB + MiB / 2) / 2; g.N = 2048; g.K = 256; eb.O = KB; eb.O2 = (bf16*)a.out; eb.ldc = 1536; eb.ps_in = PS2; eb.off4 = 2; eb.n4 = 1; eb.inv_dim = 1.f / 256.f; eb.mode = 2; }
                else if (k == 3) kind = K_PREP;
                else if (k == 4) kind = K_ATTN;
                else if (k == 5) { kind = K_RES; g.A = BIG; g.lda = 1024; g.Bt = mix + (4 * MiB + MiB / 2) / 2; g.N = DM; g.K = DM; }
            } else {
                if (k == 0) { kind = K_BF16; g.A = XB; g.lda = DM; g.Bt = mix; g.N = 4608; g.K = DM; eb.ldc = 4608; eb.mode = 3; eb.gq = a.in[26]; eb.gk = a.in[27]; eb.nq = 2; eb.nke = 4; }
                else if (k == 1) { }
                else if (k == 2) kind = K_ATTN;
                else if (k == 3) kind = K_MERGE;
                else if (k == 4) { kind = K_RES; g.A = BIG + 512; g.lda = 4608; g.Bt = mix + 9 * MiB / 2; g.N = DM; g.K = 512; }
            }
        }
        if (kind == K_NOP) continue;
        if (kind == K_CONV) conv_phase(a, L, lds, gw, NGW, lane, wave);
        else if (kind == K_SWIGLU) { pg8::StaticOrder S; S.init(M, g.N, G, bx); pg8::EpiSwiglu E{BIG, PS}; pg8::gemm_phase<pg8::EpiSwiglu, pg8::StaticOrder, true, true>(lds, g, S, E); }
        else if (kind == K_RES) { pg8::StaticOrder S; S.init(M, g.N, G, bx); pg8::EpiRes E{step == 4 * SPL - 1 ? a.out : (float*)nullptr, XB, PS, alpha}; pg8::gemm_phase<pg8::EpiRes, pg8::StaticOrder, true, true>(lds, g, S, E); }
        else if (kind == K_BF16) { pg8::StaticOrder S; S.init(M, g.N, G, bx); pg8::gemm_phase<pg8::EpiBf16, pg8::StaticOrder, true, true>(lds, g, S, eb); }
        else if (kind == K_PREP) {
            if (L == 0) prep64(BIG, 0, a.in[12], a.in[13], gw, NGW, lane);
            else if (L == 1) prep_mla(QRAW, KB, BIG, a.in[22], a.in[23], gw, NGW, lane);
            else if (L == 2) prep64(BIG, 2, a.in[26], a.in[27], gw, NGW, lane);
            else prep64(BIG, 3, a.in[30], a.in[31], gw, NGW, lane);
        }
        else if (kind == K_ATTN) {
            if (L == 1) { const float mb2 = att::logit_bound2<96>(a.in[22], a.in[23], lane); DecB d{QRAW, KB, (const bf16*)a.out, BIG}; attn_phase<96, DecB>(lds, G, vcu, 512, 512, d, mb2); }
            else if (L == 2) { const float mb2 = att::logit_bound2<64>(a.in[26], a.in[27], lane); DecC d{BIG, LSE}; attn_phase<64, DecC>(lds, G, vcu, 1536, 2048, d, mb2); }
            else { const float mb2 = att::logit_bound2<64>(L == 0 ? a.in[12] : a.in[30], L == 0 ? a.in[13] : a.in[31], lane);
                   DecAD d{BIG, L == 0 ? a.in[14] : (const float*)nullptr, L == 0 ? 128 : 0, L == 0 ? (bf16*)nullptr : BIG + 48 * MiB, 1024, L == 0 ? 0 : 1}; attn_phase<64, DecAD>(lds, G, vcu, L == 0 ? 1024 : 512, L == 0 ? 1024 : 512, d, mb2); }
        }
        else if (kind == K_MERGE) merge_c(BIG, LSE, gw, NGW, lane);
        if (nosync || step == 4 * SPL - 1) continue;
        if (step == 0) grid.sync();
        else xcd_barrier(xbar);
    }
}

extern "C" void kernel_launch(void* const* d_in, const int* in_sizes, int n_in, void* d_out, int out_size, void* d_ws, size_t ws_size, hipStream_t stream) {
    static int grid = 0;
    if (grid == 0) {
        if (n_in != 33 || out_size != M * DM || ws_size < WS_END) { fprintf(stderr, "kernel_launch: unexpected shapes (n_in %d, out %d, ws %zu)\n", n_in, out_size, ws_size); grid = -1; return; }
        int dev = 0, cus = 0, per_cu = 0;
        hipGetDevice(&dev); hipDeviceGetAttribute(&cus, hipDeviceAttributeMultiprocessorCount, dev);
        hipFuncSetAttribute((const void*)fwd_megakernel, hipFuncAttributeMaxDynamicSharedMemorySize, LDS_BYTES);
        hipOccupancyMaxActiveBlocksPerMultiprocessor(&per_cu, (const void*)fwd_megakernel, NWAVES * 64, LDS_BYTES);
        if (per_cu < 1) per_cu = 1;
        (void)hipGetLastError();
        grid = cus * per_cu;
    }
    if (grid < 0) return;
    if (hipMemsetAsync(d_ws, 0, 65536, stream) != hipSuccess) { fprintf(stderr, "kernel_launch: memset of barrier words failed\n"); return; }
    Args a{};
    for (int i = 0; i < 33; ++i) a.in[i] = (const float*)d_in[i];
    a.out = (float*)d_out; a.ws = (unsigned char*)d_ws;
    void* kargs[] = {&a};
    hipError_t e = hipLaunchCooperativeKernel((const void*)fwd_megakernel, dim3(grid), dim3(NWAVES * 64), kargs, LDS_BYTES, stream);
    if (e != hipSuccess) fprintf(stderr, "cooperative launch failed: %s (grid %d)\n", hipGetErrorString(e), grid);
}
```
